# Optimizing an MI355X kernel written in HIP

```python
import jax, jax.numpy as jnp
from jax import lax
import numpy as np

D_MODEL = 2048
BATCH = 8
SEQ = 2048
DEPTH = 1

D_MIX = D_MODEL
D_CONV = D_MIX // 2
D_ATTN = D_MIX - D_CONV
HEAD_DIM = 64
N_HEADS = D_ATTN // HEAD_DIM
CONV_WIDTH = 3
DILATED_BRANCHES = ((128, 1), (512, 4), (2048, 16))
N_PROJ = 4 * D_CONV + 4 * D_ATTN
EPS = 1e-6
NEG_INF = -1e30

kernel_name = "hybrid_conv_dilated_attn_block"


def rms_norm(x, gain):
    xf = x.astype(jnp.float32)
    y = xf * lax.rsqrt(jnp.mean(xf * xf, axis=-1, keepdims=True) + EPS)
    return (y * gain.astype(jnp.float32)).astype(x.dtype)


def alibi_slopes(n_heads):
    return 2.0 ** (-8.0 * jnp.arange(1, n_heads + 1, dtype=jnp.float32) / n_heads)


def short_conv_centred(u, w, b):
    ch = u.shape[-1]
    pad = CONV_WIDTH // 2
    y = lax.conv_general_dilated(
        u, w[:, None, :].astype(u.dtype), window_strides=(1,), padding=((pad, pad),),
        dimension_numbers=("NWC", "WIO", "NWC"), feature_group_count=ch)
    return y + b.astype(u.dtype)


def dilated_branch(q, k, v, slopes, window, dilation):
    bsz, n_heads, seq, hd = q.shape
    r = dilation
    n = (window // 2) // r
    L = seq // r
    nb = -(-L // n)
    Lp = nb * n

    def to_res(t):
        return t.reshape(bsz, n_heads, L, r, hd).transpose(0, 1, 3, 2, 4)

    qb = jnp.pad(to_res(q), ((0, 0), (0, 0), (0, 0), (0, Lp - L), (0, 0)))
    qb = qb.reshape(bsz, n_heads, r, nb, n, hd)
    kv_pad = ((0, 0), (0, 0), (0, 0), (n, Lp - L + n), (0, 0))
    kb = jnp.pad(to_res(k), kv_pad).reshape(bsz, n_heads, r, nb + 2, n, hd)
    vb = jnp.pad(to_res(v), kv_pad).reshape(bsz, n_heads, r, nb + 2, n, hd)
    shifts = (slice(0, nb), slice(1, nb + 1), slice(2, nb + 2))

    s = jnp.concatenate(
        [jnp.einsum("bhrnqd,bhrnkd->bhrnqk", qb, kb[:, :, :, sl]) for sl in shifts],
        axis=-1).astype(jnp.float32) * (hd ** -0.5)

    qi = jnp.arange(n)
    ki = jnp.arange(3 * n)
    blk = jnp.arange(nb)
    off = ki[None, :] - n - qi[:, None]
    key_idx = blk[:, None] * n + ki[None, :] - n
    valid = (jnp.abs(off) <= n)[None] & ((key_idx >= 0) & (key_idx < L))[:, None, :]
    dist = (r * jnp.abs(off)).astype(jnp.float32)
    bias = -slopes[:, None, None] * dist[None]
    s = jnp.where(valid[None, None, None], s + bias[None, :, None, None], NEG_INF)

    m = jnp.max(s, axis=-1, keepdims=True)
    p = jnp.exp(s - m)
    den = jnp.sum(p, axis=-1, keepdims=True)
    o = jnp.einsum("bhrnqk,bhrnkd->bhrnqd", p[..., 0:n], vb[:, :, :, shifts[0]].astype(jnp.float32))
    o = o + jnp.einsum("bhrnqk,bhrnkd->bhrnqd", p[..., n:2 * n], vb[:, :, :, shifts[1]].astype(jnp.float32))
    o = o + jnp.einsum("bhrnqk,bhrnkd->bhrnqd", p[..., 2 * n:], vb[:, :, :, shifts[2]].astype(jnp.float32))
    o = o / den
    lse = (m + jnp.log(den))[..., 0]

    o = o.reshape(bsz, n_heads, r, Lp, hd)[:, :, :, :L]
    o = o.transpose(0, 1, 3, 2, 4).reshape(bsz, n_heads, seq, hd)
    lse = lse.reshape(bsz, n_heads, r, Lp)[..., :L]
    lse = lse.transpose(0, 1, 3, 2).reshape(bsz, n_heads, seq)
    return o, lse


def dilated_mixture_attention(q, k, v):
    slopes = alibi_slopes(q.shape[1])
    outs, lses = [], []
    for window, dilation in DILATED_BRANCHES:
        o, lse = dilated_branch(q, k, v, slopes, window, dilation)
        outs.append(o)
        lses.append(lse)
    alpha = jax.nn.softmax(jnp.stack(lses, axis=0), axis=0)
    return jnp.sum(alpha[..., None] * jnp.stack(outs, axis=0), axis=0)


def hybrid_layer(x, mod, g_pre, w_in, conv_w, conv_b, g_conv, g_attn, w_out, g_post):
    bsz, seq, _ = x.shape
    shift, scale, gate = jnp.split(mod, 3, axis=-1)
    h = rms_norm(x, g_pre) * (1.0 + scale[:, None, :]) + shift[:, None, :]

    proj = jnp.einsum("bsd,dn->bsn", h, w_in)
    cuts = np.cumsum([D_CONV, D_CONV, D_CONV, D_CONV, D_ATTN, D_ATTN, D_ATTN])
    u, b_gate, c_gate, z_c, q, k, v, z_a = jnp.split(proj, cuts, axis=-1)

    y_c = b_gate * short_conv_centred(c_gate * u, conv_w, conv_b)
    y_c = rms_norm(y_c, g_conv) * jax.nn.silu(z_c)

    def heads(t):
        return t.reshape(bsz, seq, N_HEADS, HEAD_DIM).transpose(0, 2, 1, 3)
    o = dilated_mixture_attention(heads(q), heads(k), heads(v))
    y_a = o.transpose(0, 2, 1, 3).reshape(bsz, seq, D_ATTN).astype(x.dtype)
    y_a = rms_norm(y_a, g_attn) * jax.nn.silu(z_a)

    y = jnp.einsum("bsn,nd->bsd", jnp.concatenate([y_c, y_a], axis=-1), w_out)
    return x + gate[:, None, :] * rms_norm(y, g_post)


def setup_inputs(seed: int = 0) -> dict:
    key = jax.random.key(seed)
    ks = jax.random.split(key, 14)
    f32 = jnp.float32
    x = jax.random.normal(ks[0], (BATCH, SEQ, D_MODEL), f32)
    c = jax.random.normal(ks[1], (BATCH, D_MODEL), f32)
    w_ada = jax.random.normal(ks[2], (DEPTH, D_MODEL, 3 * D_MODEL), f32) * D_MODEL ** -0.5
    b_ada = 0.02 * jax.random.normal(ks[3], (DEPTH, 3 * D_MODEL), f32)
    g_pre = 1.0 + 0.05 * jax.random.normal(ks[4], (DEPTH, D_MODEL), f32)
    w_in = jax.random.normal(ks[5], (DEPTH, D_MODEL, N_PROJ), f32) * D_MODEL ** -0.5
    conv_w = jax.random.normal(ks[6], (DEPTH, CONV_WIDTH, D_CONV), f32) * CONV_WIDTH ** -0.5
    conv_b = 0.02 * jax.random.normal(ks[7], (DEPTH, D_CONV), f32)
    g_conv = 1.0 + 0.05 * jax.random.normal(ks[8], (DEPTH, D_CONV), f32)
    g_attn = 1.0 + 0.05 * jax.random.normal(ks[9], (DEPTH, D_ATTN), f32)
    w_out = jax.random.normal(ks[10], (DEPTH, D_MIX, D_MODEL), f32) * D_MIX ** -0.5
    g_post = 1.0 + 0.05 * jax.random.normal(ks[11], (DEPTH, D_MODEL), f32)
    return {"x": x, "c": c, "w_ada": w_ada, "b_ada": b_ada, "g_pre": g_pre,
            "w_in": w_in, "conv_w": conv_w, "conv_b": conv_b, "g_conv": g_conv,
            "g_attn": g_attn, "w_out": w_out, "g_post": g_post}


def reference(x, c, w_ada, b_ada, g_pre, w_in, conv_w, conv_b, g_conv, g_attn, w_out, g_post):
    c_act = jax.nn.silu(c)
    for layer in range(DEPTH):
        mod = jnp.einsum("bd,dn->bn", c_act, w_ada[layer]) + b_ada[layer]
        x = hybrid_layer(x, mod, g_pre[layer], w_in[layer], conv_w[layer], conv_b[layer],
                         g_conv[layer], g_attn[layer], w_out[layer], g_post[layer])
    return x
```

```cpp
#include <hip/hip_runtime.h>
#include <hip/hip_cooperative_groups.h>
#include <cstdio>
#include <cstdint>
namespace cg = cooperative_groups;
namespace pg8 {
#define PG8_LAS __attribute__((address_space(3)))
typedef unsigned short bf16_t;
typedef short bf16x8 __attribute__((ext_vector_type(8)));
typedef float f32x4 __attribute__((ext_vector_type(4)));
typedef unsigned u32x4 __attribute__((ext_vector_type(4)));
constexpr int BM = 256, BK = 64, HALF = 128, HTB = HALF * BK * 2  , STAGE_BYTES = 8 * HTB, NXCD = 8, WGM = 8;

__host__ __device__ __forceinline__ int lds_byte(int r, int c) { const int st = (r >> 4) * 2 + (c >> 5), rr = r & 15, cc = c & 31, ob = rr * 64 + cc * 2; return st * 1024 + (ob ^ (((ob >> 9) & 1) << 5)); }
__host__ __device__ __forceinline__ void stage_rc(int b, int& R, int& C) { const int st = b / 1024, sb = b % 1024, swz = sb ^ (((sb >> 9) & 1) << 5); R = (st >> 1) * 16 + swz / 64; C = (st & 1) * 32 + (swz % 64) / 2; }
__host__ __device__ __forceinline__ int perm32(int rho) { const int n = rho >> 4, i = rho & 15; return 8 * (i >> 2) + 4 * n + (i & 3); }

struct Unit { int pm, pn; };
struct Gemm { const bf16_t* A; const bf16_t* Bt; int M, N, K; };

struct StaticOrder {
    int nM, nN, nwg, G, c;
    __host__ __device__ void init(int M, int N, int G_, int c_) { nM = M / BM; nN = N / BM; nwg = nM * nN; G = G_; c = c_; }
    __host__ __device__ bool next(int i, Unit& u) const {
        const long L = (long)i * G + c; if (L >= nwg) return false;
        int wgid = (int)L; { const int q = nwg / NXCD, r = nwg % NXCD, xcd = wgid % NXCD, off = wgid / NXCD; wgid = (xcd < r ? xcd * (q + 1) : r * (q + 1) + (xcd - r) * q) + off; }
        const int nig = WGM * nN, gid = wgid / nig, fm = gid * WGM, gsz = (nM - fm) < WGM ? (nM - fm) : WGM;
        u.pm = fm + ((wgid % nig) % gsz); u.pn = (wgid % nig) / gsz; return true;
    }
    __device__ __forceinline__ void a_ready(const Unit&) const {}
    __device__ __forceinline__ void done(const Unit&) const {}
};

__device__ __forceinline__ unsigned cvt_pk_bf16(float lo, float hi) { unsigned r; asm volatile("v_cvt_pk_bf16_f32 %0, %1, %2" : "=v"(r) : "v"(lo), "v"(hi)); return r; }
typedef float f32x2 __attribute__((ext_vector_type(2)));
__device__ __forceinline__ f32x2 gelu_pk(f32x2 v) {
    const f32x2 av = __builtin_elementwise_abs(v), d = av * 0.2316418882f + 1.0f;
    f32x2 t; t.x = __builtin_amdgcn_rcpf(d.x); t.y = __builtin_amdgcn_rcpf(d.y);
    f32x2 q = t * 0.5307027145f + (-0.7265760135f); q = q * t + 0.7107068705f; q = q * t + (-0.142248368f); q = q * t + 0.127414796f; q = q * t;
    const f32x2 s = (v * v) * (-0.72134752044f);
    f32x2 e; e.x = __builtin_amdgcn_exp2f(s.x); e.y = __builtin_amdgcn_exp2f(s.y);
    const f32x2 m = v * (q * e), r = v - m;
    f32x2 o; o.x = v.x < 0.f ? m.x : r.x; o.y = v.y < 0.f ? m.y : r.y; return o;
}

template <int ACT  > struct EpiBf16 {
    static constexpr bool PERM = true, AFTER_DRAIN = false; static_assert(ACT == 0 || ACT == 1, "EpiBf16: ACT is 0 (none) or 1 (gelu_pk)");
    bf16_t* O; int ldc; const float* bias; int split_cols; size_t split_stride; float scale0;
    __device__ __forceinline__ void operator()(const f32x4 (&acc)[2][2][4][2], const Unit& u, int wr, int wc, int fr, int fq) const {
        const int row0 = u.pm * BM + wr * 64 + fr; int colt = u.pn * BM; bf16_t* base = O;
        float sc = 1.f; if (split_cols) { const int t = colt / split_cols; base += (size_t)t * split_stride; colt -= t * split_cols; if (t == 0) sc = scale0; }
        const int col0 = colt + wc * 32 + 8 * fq, bcol0 = u.pn * BM + wc * 32 + 8 * fq;
        f32x4 bv[2][2];
#pragma unroll
        for (int bj = 0; bj < 2; ++bj)
#pragma unroll
            for (int n = 0; n < 2; ++n) bv[bj][n] = bias ? *(const f32x4*)(bias + bcol0 + bj * HALF + 4 * n) : (f32x4){0.f, 0.f, 0.f, 0.f};
#pragma unroll
        for (int ai = 0; ai < 2; ++ai)
#pragma unroll
            for (int m = 0; m < 4; ++m) { bf16_t* rowp = base + (size_t)(row0 + ai * HALF + m * 16) * ldc + col0;
#pragma unroll
                for (int bj = 0; bj < 2; ++bj) { f32x4 v0 = acc[ai][bj][m][0] + bv[bj][0], v1 = acc[ai][bj][m][1] + bv[bj][1];
                    if (ACT == 1) { f32x2 a = gelu_pk((f32x2){v0[0], v0[1]}), b = gelu_pk((f32x2){v0[2], v0[3]}), c = gelu_pk((f32x2){v1[0], v1[1]}), d = gelu_pk((f32x2){v1[2], v1[3]});
                        v0 = (f32x4){a.x, a.y, b.x, b.y}; v1 = (f32x4){c.x, c.y, d.x, d.y}; }
                    v0 = v0 * sc; v1 = v1 * sc; u32x4 w; w.x = cvt_pk_bf16(v0[0], v0[1]); w.y = cvt_pk_bf16(v0[2], v0[3]); w.z = cvt_pk_bf16(v1[0], v1[1]); w.w = cvt_pk_bf16(v1[2], v1[3]);
                    *(u32x4*)(rowp + bj * HALF) = w; } }
    }
};
struct EpiY {
    static constexpr bool PERM = true, AFTER_DRAIN = false;
    bf16_t* Y; int ldc; float* ssq;
    __device__ __forceinline__ void operator()(const f32x4 (&acc)[2][2][4][2], const Unit& u, int wr, int wc, int fr, int fq) const {
        const int row0 = u.pm * BM + wr * 64 + fr; const int col0 = u.pn * BM + wc * 32 + 8 * fq;
#pragma unroll
        for (int ai = 0; ai < 2; ++ai)
#pragma unroll
            for (int m = 0; m < 4; ++m) { const int row = row0 + ai * HALF + m * 16; bf16_t* rowp = Y + (size_t)row * ldc + col0; float ss = 0.f;
#pragma unroll
                for (int bj = 0; bj < 2; ++bj) { const f32x4 v0 = acc[ai][bj][m][0], v1 = acc[ai][bj][m][1];
                    ss += (v0[0] * v0[0] + v0[1] * v0[1]) + (v0[2] * v0[2] + v0[3] * v0[3]) + (v1[0] * v1[0] + v1[1] * v1[1]) + (v1[2] * v1[2] + v1[3] * v1[3]);
                    u32x4 w; w.x = cvt_pk_bf16(v0[0], v0[1]); w.y = cvt_pk_bf16(v0[2], v0[3]); w.z = cvt_pk_bf16(v1[0], v1[1]); w.w = cvt_pk_bf16(v1[2], v1[3]);
                    *(u32x4*)(rowp + bj * HALF) = w; }
                ss += __shfl_xor(ss, 16); ss += __shfl_xor(ss, 32);
                if (fq == 0) ssq[(size_t)row * 32 + u.pn * 4 + wc] = ss; }
    }
};
template <class Epi, class Sched, bool ALIGN_EPI = false, bool SP2 = false>
__device__ __forceinline__ void gemm_phase(PG8_LAS unsigned char* lds, const Gemm g, const Sched& S, const Epi& E) {
    const int tid = threadIdx.x, wid = __builtin_amdgcn_readfirstlane(tid >> 6), lane = tid & 63, wr = wid >> 2, wc = wid & 3, fr = lane & 15, fq = lane >> 4;
    const int K = g.K, nt = K / BK;
    unsigned voffA[2], voffB[2];
#pragma unroll
    for (int i = 0; i < 2; ++i) { int R, C; stage_rc(tid * 16 + i * 8192, R, C); const int Rb = Epi::PERM ? ((R & ~31) + perm32(R & 31)) : R;
        voffA[i] = (unsigned)(R * K + C) * 2u; voffB[i] = (unsigned)(Rb * K + C) * 2u; }
    const size_t kstep = (size_t)(BK * 2);
    const size_t hstep = (size_t)HALF * K * 2;
    const size_t tstep = 2 * hstep;
    const unsigned ldsw = (unsigned)wid * 1024u;
    const int aoff = lds_byte(wr * 64 + fr, fq * 8), boff = lds_byte(wc * 32 + fr, fq * 8);
#define PG8_SA(b, h) (((b) * 2 + (h)) * HTB)
#define PG8_SB(b, h) ((4 + (b) * 2 + (h)) * HTB)
#define PG8_STAGE(bufoff, gbase, voff) do { _Pragma("unroll") for (int _i = 0; _i < 2; ++_i) \
        __builtin_amdgcn_global_load_lds((const unsigned*)((const char*)(gbase) + (voff)[_i]), (PG8_LAS unsigned*)(lds + (bufoff) + ldsw + _i * 8192), 16, 0, 0); } while (0)
#define PG8_LDA(dst, b, h) do { _Pragma("unroll") for (int m = 0; m < 4; ++m) _Pragma("unroll") for (int k = 0; k < 2; ++k) dst[m][k] = *(const PG8_LAS bf16x8*)(lds + PG8_SA(b, h) + aoff + m * 2048 + k * 1024); } while (0)
#define PG8_LDB(dst, b, h) do { _Pragma("unroll") for (int n = 0; n < 2; ++n) _Pragma("unroll") for (int k = 0; k < 2; ++k) dst[n][k] = *(const PG8_LAS bf16x8*)(lds + PG8_SB(b, h) + boff + n * 2048 + k * 1024); } while (0)
#define PG8_MMA(ai, bj, At, Bt) do { __builtin_amdgcn_s_setprio(1); _Pragma("unroll") for (int m = 0; m < 4; ++m) _Pragma("unroll") for (int n = 0; n < 2; ++n) _Pragma("unroll") for (int k = 0; k < 2; ++k) \
        acc[ai][bj][m][n] = __builtin_amdgcn_mfma_f32_16x16x32_bf16(Bt[n][k], At[m][k], acc[ai][bj][m][n], 0, 0, 0); __builtin_amdgcn_s_setprio(0); } while (0)
#define PG8_WAIT_V(n) asm volatile("s_waitcnt vmcnt(" #n ")" ::: "memory")
#define PG8_WAIT_L(n) asm volatile("s_waitcnt lgkmcnt(" #n ")" ::: "memory")
#define PG8_BAR __builtin_amdgcn_s_barrier()
#define PG8_SCHED __builtin_amdgcn_sched_barrier(0)
    Unit cur, nxt; int ui = 0;
    if (!S.next(0, cur)) return;
    f32x4 acc[2][2][4][2];
#pragma unroll
    for (int a = 0; a < 2; ++a)
#pragma unroll
        for (int b = 0; b < 2; ++b)
#pragma unroll
            for (int m = 0; m < 4; ++m)
#pragma unroll
                for (int n = 0; n < 2; ++n) acc[a][b][m][n] = (f32x4){0.f, 0.f, 0.f, 0.f};
    bf16x8 At[4][2], B0[2][2], B1[2][2];
    const char* cA = (const char*)g.A + (size_t)cur.pm * tstep; const char* cB = (const char*)g.Bt + (size_t)cur.pn * tstep;
    S.a_ready(cur);
    if constexpr (SP2) {
        PG8_STAGE(PG8_SB(0, 0), cB, voffB); PG8_STAGE(PG8_SB(0, 1), cB + hstep, voffB); PG8_STAGE(PG8_SA(0, 0), cA, voffA); PG8_STAGE(PG8_SA(0, 1), cA + hstep, voffA);
        if (wr == 1) PG8_BAR;
        PG8_WAIT_V(2); PG8_BAR;
        PG8_STAGE(PG8_SB(1, 0), cB + kstep, voffB); PG8_STAGE(PG8_SA(1, 0), cA + kstep, voffA); PG8_STAGE(PG8_SB(1, 1), cB + hstep + kstep, voffB);
        PG8_WAIT_V(6); PG8_BAR;
    } else {
        PG8_STAGE(PG8_SB(0, 0), cB, voffB); PG8_STAGE(PG8_SA(0, 0), cA, voffA); PG8_STAGE(PG8_SB(0, 1), cB + hstep, voffB); PG8_STAGE(PG8_SA(0, 1), cA + hstep, voffA);
        if (wr == 1) PG8_BAR;
        PG8_WAIT_V(4); PG8_BAR;
        PG8_STAGE(PG8_SB(1, 0), cB + kstep, voffB); PG8_STAGE(PG8_SA(1, 0), cA + kstep, voffA); PG8_STAGE(PG8_SB(1, 1), cB + hstep + kstep, voffB);
        PG8_WAIT_V(6); PG8_BAR;
    }
    for (;;) {
        const bool has_next = S.next(ui + 1, nxt);
        const char* nA = has_next ? (const char*)g.A + (size_t)nxt.pm * tstep : cA; const char* nB = has_next ? (const char*)g.Bt + (size_t)nxt.pn * tstep : cB;
        for (int t = 0; t < nt; t += 2) {
            const bool last = (t == nt - 2);
            const char* a1 = cA + (size_t)(t + 1) * kstep;
            const char* a2 = last ? nA : cA + (size_t)(t + 2) * kstep; const char* b2 = last ? nB : cB + (size_t)(t + 2) * kstep;
            const char* a3 = a2 + kstep; const char* b3 = b2 + kstep;
            if (last && has_next) S.a_ready(nxt);
            if constexpr (SP2) {
            PG8_LDB(B0, 0, 0); PG8_LDB(B1, 0, 1); PG8_SCHED; PG8_LDA(At, 0, 0); PG8_STAGE(PG8_SA(1, 1), a1 + hstep, voffA);
            PG8_WAIT_V(8); PG8_WAIT_L(0); PG8_BAR; PG8_MMA(0, 0, At, B0); PG8_MMA(0, 1, At, B1); PG8_BAR; PG8_SCHED;
            PG8_LDA(At, 0, 1); PG8_STAGE(PG8_SB(0, 0), b2, voffB); PG8_STAGE(PG8_SB(0, 1), b2 + hstep, voffB); PG8_STAGE(PG8_SA(0, 0), a2, voffA);
            PG8_WAIT_V(8); PG8_WAIT_L(0); PG8_BAR; PG8_MMA(1, 0, At, B0); PG8_MMA(1, 1, At, B1); PG8_BAR; PG8_SCHED;
            PG8_LDB(B0, 1, 0); PG8_LDB(B1, 1, 1); PG8_SCHED; PG8_LDA(At, 1, 0); PG8_STAGE(PG8_SA(0, 1), a2 + hstep, voffA);
            PG8_WAIT_V(8); PG8_WAIT_L(0); PG8_BAR; PG8_MMA(0, 0, At, B0); PG8_MMA(0, 1, At, B1); PG8_BAR; PG8_SCHED;
            PG8_LDA(At, 1, 1); PG8_STAGE(PG8_SB(1, 0), b3, voffB); PG8_STAGE(PG8_SB(1, 1), b3 + hstep, voffB); PG8_STAGE(PG8_SA(1, 0), a3, voffA);
            PG8_WAIT_V(8); PG8_WAIT_L(0); PG8_BAR; PG8_MMA(1, 0, At, B0); PG8_MMA(1, 1, At, B1); PG8_BAR; PG8_SCHED;
            } else {
            PG8_LDB(B0, 0, 0); PG8_SCHED; PG8_LDA(At, 0, 0); PG8_STAGE(PG8_SA(1, 1), a1 + hstep, voffA);
            PG8_WAIT_L(8); PG8_BAR; PG8_WAIT_L(0); PG8_MMA(0, 0, At, B0); PG8_BAR; PG8_SCHED;
            PG8_LDB(B1, 0, 1); PG8_STAGE(PG8_SB(0, 0), b2, voffB);
            PG8_BAR; PG8_WAIT_L(0); PG8_MMA(0, 1, At, B1); PG8_BAR;
            PG8_LDA(At, 0, 1); PG8_STAGE(PG8_SA(0, 0), a2, voffA);
            PG8_BAR; PG8_WAIT_L(0); PG8_MMA(1, 0, At, B0); PG8_BAR; PG8_SCHED;
            PG8_STAGE(PG8_SB(0, 1), b2 + hstep, voffB);
            PG8_WAIT_V(6); PG8_BAR; PG8_MMA(1, 1, At, B1); PG8_BAR;
            PG8_LDB(B0, 1, 0); PG8_SCHED; PG8_LDA(At, 1, 0); PG8_STAGE(PG8_SA(0, 1), a2 + hstep, voffA);
            PG8_WAIT_L(8); PG8_BAR; PG8_WAIT_L(0); PG8_MMA(0, 0, At, B0); PG8_BAR; PG8_SCHED;
            PG8_LDB(B1, 1, 1); PG8_STAGE(PG8_SB(1, 0), b3, voffB);
            PG8_BAR; PG8_WAIT_L(0); PG8_MMA(0, 1, At, B1); PG8_BAR;
            PG8_LDA(At, 1, 1); PG8_STAGE(PG8_SA(1, 0), a3, voffA);
            PG8_BAR; PG8_WAIT_L(0); PG8_MMA(1, 0, At, B0); PG8_BAR; PG8_SCHED;
            PG8_STAGE(PG8_SB(1, 1), b3 + hstep, voffB);
            PG8_WAIT_V(6); PG8_BAR; PG8_MMA(1, 1, At, B1); PG8_BAR;
            }
        }
        if constexpr (ALIGN_EPI) { if (wr == 0) PG8_BAR; }
        if constexpr (!Epi::AFTER_DRAIN) { E(acc, cur, wr, wc, fr, fq); S.done(cur); }
        if (!has_next) break;
#pragma unroll
        for (int a = 0; a < 2; ++a)
#pragma unroll
            for (int b = 0; b < 2; ++b)
#pragma unroll
                for (int m = 0; m < 4; ++m)
#pragma unroll
                    for (int n = 0; n < 2; ++n) acc[a][b][m][n] = (f32x4){0.f, 0.f, 0.f, 0.f};
        cur = nxt; cA = nA; cB = nB; ++ui;
        if constexpr (ALIGN_EPI) { if (wr == 1) PG8_BAR; }
    }
    PG8_WAIT_V(0);
    if constexpr (!ALIGN_EPI) { if (wr == 0) PG8_BAR; }
    PG8_BAR;
    if constexpr (Epi::AFTER_DRAIN) { E.fused(acc, cur, wr, wc, fr, fq, lds, wid, lane); S.done(cur); }
#undef PG8_SA
#undef PG8_SB
#undef PG8_STAGE
#undef PG8_LDA
#undef PG8_LDB
#undef PG8_MMA
#undef PG8_WAIT_V
#undef PG8_WAIT_L
#undef PG8_BAR
#undef PG8_SCHED
}
}

#ifndef PG8_SP2
#define PG8_SP2 true
#endif
#ifndef PG8_ALIGN
#define PG8_ALIGN true
#endif
#ifndef MK_N_LAUNCHES
#define MK_N_LAUNCHES 1
#endif
#ifndef ATTN_NAIVE
#define ATTN_NAIVE 1
#endif

using pg8::bf16_t; using pg8::bf16x8; using pg8::f32x4; using pg8::u32x4;
typedef unsigned u32x2 __attribute__((ext_vector_type(2)));
typedef float f32x2 __attribute__((ext_vector_type(2)));
#define LAS __attribute__((address_space(3)))
constexpr int BATCH = 8, SEQ = 2048, DM = 2048, MTOK = BATCH * SEQ, NPROJ = 8192, DG = 1024, NH = 16, HD = 64, NMOD = 3 * DM;
constexpr int OFF_U = 0, OFF_B = 1024, OFF_C = 2048, OFF_ZC = 3072, OFF_Q = 4096, OFF_K = 5120, OFF_V = 6144, OFF_ZA = 7168;
constexpr float EPS = 1e-6f, LOG2E = 1.4426950408889634f;
constexpr int KSPLIT = 16, NWAVES = 8, NPHASE = 7;
constexpr size_t MiB = 1u << 20;
constexpr size_t WS_MODP = 1 * MiB, WS_GATE = 4 * MiB, WS_SSQA = 5 * MiB, WS_SSQY = 6 * MiB, WS_WOUTT = 8 * MiB, WS_WINT = 16 * MiB, WS_O = 48 * MiB,
                 WS_H = 80 * MiB, WS_YCAT = WS_H  , WS_PROJ = 144 * MiB, WS_Y = WS_PROJ  , WS_END = 400 * MiB;
constexpr int LDS_BYTES = 147456;

#define LDS_WAIT() asm volatile("s_waitcnt lgkmcnt(0)" ::: "memory")
__device__ __forceinline__ float bf_lo(unsigned u) { return __uint_as_float(u << 16); }
__device__ __forceinline__ float bf_hi(unsigned u) { return __uint_as_float(u & 0xffff0000u); }
__device__ __forceinline__ unsigned pk(float lo, float hi) { return pg8::cvt_pk_bf16(lo, hi); }
__device__ __forceinline__ float silu_f(float v) { return v * __builtin_amdgcn_rcpf(1.f + __builtin_amdgcn_exp2f(-v * LOG2E)); }
__device__ __forceinline__ float wave_sum(float v) {
#pragma unroll
    for (int o = 1; o < 64; o <<= 1) v += __shfl_xor(v, o);
    return v;
}
__device__ __forceinline__ void unpack8(const u32x4 w, float* f) { f[0] = bf_lo(w.x); f[1] = bf_hi(w.x); f[2] = bf_lo(w.y); f[3] = bf_hi(w.y); f[4] = bf_lo(w.z); f[5] = bf_hi(w.z); f[6] = bf_lo(w.w); f[7] = bf_hi(w.w); }
__device__ __forceinline__ void load16(const bf16_t* rowp, int lane, float (&f)[16]) {
    const u32x4 a = *(const u32x4*)(rowp + 8 * lane), b = *(const u32x4*)(rowp + 512 + 8 * lane); unpack8(a, f); unpack8(b, f + 8);
}
__device__ __forceinline__ void load16f(const float* p, int lane, float (&f)[16]) {
#pragma unroll
    for (int j = 0; j < 2; ++j) { const f32x4 a = *(const f32x4*)(p + 512 * j + 8 * lane), b = *(const f32x4*)(p + 512 * j + 8 * lane + 4);
        f[8 * j + 0] = a[0]; f[8 * j + 1] = a[1]; f[8 * j + 2] = a[2]; f[8 * j + 3] = a[3]; f[8 * j + 4] = b[0]; f[8 * j + 5] = b[1]; f[8 * j + 6] = b[2]; f[8 * j + 7] = b[3]; }
}
__device__ __forceinline__ void store16(bf16_t* rowp, int lane, const float (&y)[16]) {
#pragma unroll
    for (int j = 0; j < 2; ++j) { u32x4 w; w.x = pk(y[8 * j + 0], y[8 * j + 1]); w.y = pk(y[8 * j + 2], y[8 * j + 3]); w.z = pk(y[8 * j + 4], y[8 * j + 5]); w.w = pk(y[8 * j + 6], y[8 * j + 7]);
        *(u32x4*)(rowp + 512 * j + 8 * lane) = w; }
}

__device__ __forceinline__ void p0_transpose_item(const float* __restrict__ W, int K, int N, bf16_t* __restrict__ WT, LAS float* scr, int item, int lane) {
    const int nblk = N / 32, kb = item / nblk, nb = item % nblk, k0 = 64 * kb, n0 = 32 * nb;
#pragma unroll 8
    for (int i = 0; i < 32; ++i) { const int kk = 2 * i + (lane >> 5); scr[kk * 33 + (lane & 31)] = W[(size_t)(k0 + kk) * N + n0 + (lane & 31)]; }
    LDS_WAIT();
    const int c = lane & 7;
#pragma unroll
    for (int j = 0; j < 4; ++j) { const int n = (lane >> 3) + 8 * j; const LAS float* s = scr + (8 * c) * 33 + n;
        u32x4 o; o.x = pk(s[0 * 33], s[1 * 33]); o.y = pk(s[2 * 33], s[3 * 33]); o.z = pk(s[4 * 33], s[5 * 33]); o.w = pk(s[6 * 33], s[7 * 33]);
        *(u32x4*)(WT + (size_t)(n0 + n) * K + k0 + 8 * c) = o; }
    LDS_WAIT();
}
__device__ __forceinline__ void p0_mod_item(const float* __restrict__ cvec, const float* __restrict__ wada, float* __restrict__ modp, LAS float* scr, int item, int lane) {
    const int kc = item / 48, nc = item % 48, k0 = kc * 128, n0 = nc * 128;
#pragma unroll
    for (int i = 0; i < 16; ++i) { const int idx = i * 64 + lane, b = idx >> 7, kk = idx & 127; scr[kk * 8 + b] = silu_f(cvec[b * DM + k0 + kk]); }
    LDS_WAIT();
    float acc[8][2];
#pragma unroll
    for (int b = 0; b < 8; ++b) { acc[b][0] = 0.f; acc[b][1] = 0.f; }
    const float* wp = wada + (size_t)k0 * NMOD + n0 + 2 * lane;
#pragma unroll 8
    for (int kk = 0; kk < 128; ++kk) {
        const f32x2 w = *(const f32x2*)(wp + (size_t)kk * NMOD);
        const f32x4 s0 = *(const LAS f32x4*)(scr + kk * 8), s1 = *(const LAS f32x4*)(scr + kk * 8 + 4);
        acc[0][0] += s0[0] * w[0]; acc[0][1] += s0[0] * w[1]; acc[1][0] += s0[1] * w[0]; acc[1][1] += s0[1] * w[1];
        acc[2][0] += s0[2] * w[0]; acc[2][1] += s0[2] * w[1]; acc[3][0] += s0[3] * w[0]; acc[3][1] += s0[3] * w[1];
        acc[4][0] += s1[0] * w[0]; acc[4][1] += s1[0] * w[1]; acc[5][0] += s1[1] * w[0]; acc[5][1] += s1[1] * w[1];
        acc[6][0] += s1[2] * w[0]; acc[6][1] += s1[2] * w[1]; acc[7][0] += s1[3] * w[0]; acc[7][1] += s1[3] * w[1];
    }
#pragma unroll
    for (int b = 0; b < 8; ++b) *(f32x2*)(modp + ((size_t)kc * 8 + b) * NMOD + n0 + 2 * lane) = (f32x2){acc[b][0], acc[b][1]};
    LDS_WAIT();
}

__device__ __forceinline__ void p1_rows(const float* __restrict__ x, const float* __restrict__ b_ada, const float* __restrict__ g_pre, const float* __restrict__ modp,
                                        float* __restrict__ gate, bf16_t* __restrict__ hbuf, LAS unsigned char* lds, int bx, int G, int tid, int wave, int lane) {
    LAS float* Ac = (LAS float*)lds; LAS float* Sc = Ac + DM;
    for (int chunk = bx; chunk < MTOK / 64; chunk += G) {
        const int b = chunk >> 5;
        __syncthreads();
        { const int d = tid * 4;
          f32x4 sh = *(const f32x4*)(b_ada + d), sc = *(const f32x4*)(b_ada + DM + d);
#pragma unroll 4
          for (int kc = 0; kc < KSPLIT; ++kc) { const float* p = modp + ((size_t)kc * 8 + b) * NMOD + d; sh += *(const f32x4*)p; sc += *(const f32x4*)(p + DM); }
          const f32x4 g = *(const f32x4*)(g_pre + d);
          *(LAS f32x4*)(Ac + d) = g * (sc + 1.0f); *(LAS f32x4*)(Sc + d) = sh;
          if ((chunk & 31) == 0) { f32x4 gt = *(const f32x4*)(b_ada + 2 * DM + d);
#pragma unroll 4
              for (int kc = 0; kc < KSPLIT; ++kc) gt += *(const f32x4*)(modp + ((size_t)kc * 8 + b) * NMOD + 2 * DM + d);
              *(f32x4*)(gate + b * DM + d) = gt; } }
        __syncthreads();
        for (int i = 0; i < 8; ++i) {
            const int row = chunk * 64 + wave * 8 + i;
            const f32x4* xr = (const f32x4*)(x + (size_t)row * DM) + lane;
            f32x4 v[8]; float s = 0.f;
#pragma unroll
            for (int j = 0; j < 8; ++j) { v[j] = xr[64 * j]; s += (v[j][0] * v[j][0] + v[j][1] * v[j][1]) + (v[j][2] * v[j][2] + v[j][3] * v[j][3]); }
            const float rstd = 1.0f / sqrtf(wave_sum(s) * (1.0f / DM) + EPS);
            u32x2* o8 = (u32x2*)(hbuf + (size_t)row * DM) + lane;
#pragma unroll
            for (int j = 0; j < 8; ++j) { const int d = 4 * lane + 256 * j; const f32x4 a = *(const LAS f32x4*)(Ac + d), sft = *(const LAS f32x4*)(Sc + d);
                const f32x4 o = v[j] * rstd * a + sft; u32x2 w; w.x = pk(o[0], o[1]); w.y = pk(o[2], o[3]); o8[64 * j] = w; }
        }
    }
}

__device__ __forceinline__ void conv_unit(const bf16_t* __restrict__ proj, const float* __restrict__ cw, const float* __restrict__ cb, const float* __restrict__ gc,
                                          bf16_t* __restrict__ ycat, int unit, int wave, int lane) {
    const int tk0 = unit * 64 + wave * 8, t0 = tk0 & (SEQ - 1);
    float w0[16], w1[16], w2[16], bb[16];
    load16f(cw, lane, w0); load16f(cw + DG, lane, w1); load16f(cw + 2 * DG, lane, w2); load16f(cb, lane, bb);
    float pp[16], pc[16], pn[16], ta[16], tb[16];
    const bf16_t* base = proj + (size_t)tk0 * NPROJ;
    if (t0 > 0) { load16(base - NPROJ + OFF_C, lane, ta); load16(base - NPROJ + OFF_U, lane, tb);
#pragma unroll
        for (int e = 0; e < 16; ++e) pp[e] = ta[e] * tb[e]; }
    else {
#pragma unroll
        for (int e = 0; e < 16; ++e) pp[e] = 0.f; }
    load16(base + OFF_C, lane, ta); load16(base + OFF_U, lane, tb);
#pragma unroll
    for (int e = 0; e < 16; ++e) pc[e] = ta[e] * tb[e];
#pragma unroll 1
    for (int i = 0; i < 8; ++i) {
        const bf16_t* rp = base + (size_t)i * NPROJ;
        if (t0 + i + 1 < SEQ) { load16(rp + NPROJ + OFF_C, lane, ta); load16(rp + NPROJ + OFF_U, lane, tb);
#pragma unroll
            for (int e = 0; e < 16; ++e) pn[e] = ta[e] * tb[e]; }
        else {
#pragma unroll
            for (int e = 0; e < 16; ++e) pn[e] = 0.f; }
        load16(rp + OFF_B, lane, ta); load16(rp + OFF_ZC, lane, tb);
        float v[16], ss = 0.f;
#pragma unroll
        for (int e = 0; e < 16; ++e) { v[e] = ta[e] * (w0[e] * pp[e] + w1[e] * pc[e] + w2[e] * pn[e] + bb[e]); ss += v[e] * v[e]; }
        const float rstd = 1.0f / sqrtf(wave_sum(ss) * (1.0f / DG) + EPS);
        float g[16]; load16f(gc, lane, g);
#pragma unroll
        for (int e = 0; e < 16; ++e) v[e] = v[e] * rstd * g[e] * silu_f(tb[e]);
        store16(ycat + (size_t)(tk0 + i) * DM, lane, v);
#pragma unroll
        for (int e = 0; e < 16; ++e) { pp[e] = pc[e]; pc[e] = pn[e]; }
    }
}

#if ATTN_NAIVE
__device__ __forceinline__ void attn_naive_item(const bf16_t* __restrict__ proj, bf16_t* __restrict__ obuf, float* __restrict__ ssqa, int item, int tid) {
    const int bh = item >> 2, b = bh >> 4, h = bh & 15, t = (item & 3) * 512 + tid;
    const size_t tokb = (size_t)b * SEQ;
    float q[64], O[64];
    { const u32x4* qp = (const u32x4*)(proj + (tokb + t) * NPROJ + OFF_Q + h * HD);
#pragma unroll
      for (int i = 0; i < 8; ++i) { const u32x4 w = qp[i]; unpack8(w, q + 8 * i); } }
#pragma unroll
    for (int d = 0; d < 64; ++d) O[d] = 0.f;
    float M = -1e30f, Ls = 0.f;
    const float slope = exp2f(-0.5f * (float)(h + 1));
    for (int br = 0; br < 3; ++br) {
        const int R = br == 0 ? 1 : (br == 1 ? 4 : 16); const float sr = slope * (float)R;
        for (int j = -64; j <= 64; ++j) {
            const int pos = t + R * j; if (pos < 0 || pos >= SEQ) continue;
            const u32x4* kp = (const u32x4*)(proj + (tokb + pos) * NPROJ + OFF_K + h * HD); const u32x4* vp = (const u32x4*)(proj + (tokb + pos) * NPROJ + OFF_V + h * HD);
            float dot = 0.f;
#pragma unroll
            for (int i = 0; i < 8; ++i) { const u32x4 w = kp[i]; float kf[8]; unpack8(w, kf);
#pragma unroll
                for (int e = 0; e < 8; ++e) dot += q[8 * i + e] * kf[e]; }
            const float s = dot * 0.125f - sr * fabsf((float)j);
            const float mn = fmaxf(M, s), a = __expf(M - mn), p = __expf(s - mn); Ls = Ls * a + p; M = mn;
#pragma unroll
            for (int i = 0; i < 8; ++i) { const u32x4 w = vp[i]; float vf[8]; unpack8(w, vf);
#pragma unroll
                for (int e = 0; e < 8; ++e) O[8 * i + e] = O[8 * i + e] * a + p * vf[e]; }
        }
    }
    const float inv = 1.0f / Ls; float ss = 0.f;
    u32x4* op = (u32x4*)(obuf + (tokb + t) * DG + h * HD);
#pragma unroll
    for (int i = 0; i < 8; ++i) { float o[8];
#pragma unroll
        for (int e = 0; e < 8; ++e) { o[e] = O[8 * i + e] * inv; ss += o[e] * o[e]; }
        u32x4 w; w.x = pk(o[0], o[1]); w.y = pk(o[2], o[3]); w.z = pk(o[4], o[5]); w.w = pk(o[6], o[7]); op[i] = w; }
    ssqa[(tokb + t) * NH + h] = ss;
}
constexpr int NATT = BATCH * NH * 4;
#else
#endif

struct Args { const float* in[12]; float* out; unsigned char* ws; int ph_lo, ph_hi; };
__global__ void __launch_bounds__(NWAVES * 64, 2) mk_fwd(Args args) {
    extern __shared__ __attribute__((aligned(16))) unsigned char lds_raw[];
    LAS unsigned char* lds = (LAS unsigned char*)lds_raw;
    const int tid = threadIdx.x, lane = tid & 63, wave = __builtin_amdgcn_readfirstlane(tid >> 6);
    const int G = gridDim.x, bx = blockIdx.x, vcu = (G % 8 == 0) ? (bx % 8) * (G / 8) + bx / 8 : bx;
    const float *x = args.in[0], *cvec = args.in[1], *w_ada = args.in[2], *b_ada = args.in[3], *g_pre = args.in[4], *w_in = args.in[5], *conv_w = args.in[6], *conv_b = args.in[7],
                *g_conv = args.in[8], *g_attn = args.in[9], *w_out = args.in[10], *g_post = args.in[11];
    unsigned char* ws = args.ws;
    float* modp = (float*)(ws + WS_MODP); float* gate = (float*)(ws + WS_GATE); float* ssqa = (float*)(ws + WS_SSQA); float* ssqy = (float*)(ws + WS_SSQY);
    bf16_t* woutT = (bf16_t*)(ws + WS_WOUTT); bf16_t* winT = (bf16_t*)(ws + WS_WINT); bf16_t* obuf = (bf16_t*)(ws + WS_O); bf16_t* hbuf = (bf16_t*)(ws + WS_H);
    bf16_t* ycat = (bf16_t*)(ws + WS_YCAT); bf16_t* proj = (bf16_t*)(ws + WS_PROJ); bf16_t* ybuf = (bf16_t*)(ws + WS_Y);
    const int lo = args.ph_lo, hi = args.ph_hi;
    const int gw = bx * NWAVES + wave, NGW = G * NWAVES;
#define IN(k) (lo <= (k) && (k) < hi)
#define SEAM(k) do { if (IN(k) && IN((k) + 1)) { cg::this_grid().sync(); } } while (0)

    if (IN(0)) {
        LAS float* scr = (LAS float*)(lds + wave * 16384);
        constexpr int I_MOD = KSPLIT * 48, I_IN = (DM / 64) * (NPROJ / 32), I_OUT = (DM / 64) * (DM / 32);
        for (int it = gw; it < I_MOD + I_IN + I_OUT; it += NGW) {
            if (it < I_MOD) p0_mod_item(cvec, w_ada, modp, scr, it, lane);
            else if (it < I_MOD + I_IN) p0_transpose_item(w_in, DM, NPROJ, winT, scr, it - I_MOD, lane);
            else p0_transpose_item(w_out, DM, DM, woutT, scr, it - I_MOD - I_IN, lane);
        }
    }
    SEAM(0);
    if (IN(1)) p1_rows(x, b_ada, g_pre, modp, gate, hbuf, lds, bx, G, tid, wave, lane);
    SEAM(1);
    if (IN(2)) {
        pg8::Gemm g{hbuf, winT, MTOK, NPROJ, DM}; pg8::StaticOrder S; S.init(MTOK, NPROJ, G, bx);
        pg8::EpiBf16<0> E{proj, NPROJ, nullptr, 0, 0, 1.f};
        pg8::gemm_phase<pg8::EpiBf16<0>, pg8::StaticOrder, PG8_ALIGN, PG8_SP2>(lds, g, S, E);
    }
    SEAM(2);
    if (IN(3)) {
        for (int it = vcu; it < NATT + MTOK / 64; it += G) {
            if (it < NATT) {
#if ATTN_NAIVE
                attn_naive_item(proj, obuf, ssqa, it, tid);
#else
                attn_unit(proj, obuf, ssqa, lds, it, wave, lane);
#endif
            } else conv_unit(proj, conv_w, conv_b, g_conv, ycat, it - NATT, wave, lane);
        }
    }
    SEAM(3);
    if (IN(4)) {
        for (int row = gw; row < MTOK; row += NGW) {
            const float sv = lane < NH ? ssqa[(size_t)row * NH + lane] : 0.f;
            const float rstd = 1.0f / sqrtf(wave_sum(sv) * (1.0f / DG) + EPS);
            float ov[16], zv[16], g[16];
            load16(obuf + (size_t)row * DG, lane, ov); load16(proj + (size_t)row * NPROJ + OFF_ZA, lane, zv); load16f(g_attn, lane, g);
#pragma unroll
            for (int e = 0; e < 16; ++e) ov[e] = ov[e] * rstd * g[e] * silu_f(zv[e]);
            store16(ycat + (size_t)row * DM + DG, lane, ov);
        }
    }
    SEAM(4);
    if (IN(5)) {
        pg8::Gemm g{ycat, woutT, MTOK, DM, DM}; pg8::StaticOrder S; S.init(MTOK, DM, G, bx);
        pg8::EpiY E{ybuf, DM, ssqy};
        pg8::gemm_phase<pg8::EpiY, pg8::StaticOrder, PG8_ALIGN, PG8_SP2>(lds, g, S, E);
    }
    SEAM(5);
    if (IN(6)) {
        for (int row = gw; row < MTOK; row += NGW) {
            const int b = row >> 11;
            const float sv = lane < 32 ? ssqy[(size_t)row * 32 + lane] : 0.f;
            const float rstd = 1.0f / sqrtf(wave_sum(sv) * (1.0f / DM) + EPS);
#pragma unroll
            for (int j = 0; j < 4; ++j) { const int c = 512 * j + 8 * lane; const size_t off = (size_t)row * DM + c;
                const u32x4 yw = *(const u32x4*)(ybuf + off); float yv[8]; unpack8(yw, yv);
                const f32x4 x0 = *(const f32x4*)(x + off), x1 = *(const f32x4*)(x + off + 4), g0 = *(const f32x4*)(gate + b * DM + c), g1 = *(const f32x4*)(gate + b * DM + c + 4),
                            p0 = *(const f32x4*)(g_post + c), p1 = *(const f32x4*)(g_post + c + 4);
                f32x4 o0, o1;
#pragma unroll
                for (int e = 0; e < 4; ++e) { o0[e] = x0[e] + g0[e] * p0[e] * (yv[e] * rstd); o1[e] = x1[e] + g1[e] * p1[e] * (yv[4 + e] * rstd); }
                *(f32x4*)(args.out + off) = o0; *(f32x4*)(args.out + off + 4) = o1; }
        }
    }
#undef IN
#undef SEAM
}

extern "C" void kernel_launch(void* const* d_in, const int* in_sizes, int n_in, void* d_out, int out_size, void* d_ws, size_t ws_size, hipStream_t stream) {
    static int grid = 0;
    if (grid == 0) {
        if (n_in != 12 || in_sizes[0] != MTOK * DM || out_size != MTOK * DM || ws_size < WS_END) { fprintf(stderr, "kernel_launch: unexpected problem (n_in %d, in0 %d, out %d, ws %zu); nothing launched\n", n_in, n_in > 0 ? in_sizes[0] : -1, out_size, ws_size); grid = -1; return; }
        int dev = 0, cus = 0, per_cu = 0;
        if (hipGetDevice(&dev) != hipSuccess || hipDeviceGetAttribute(&cus, hipDeviceAttributeMultiprocessorCount, dev) != hipSuccess) { grid = -1; return; }
        if (hipFuncSetAttribute((const void*)mk_fwd, hipFuncAttributeMaxDynamicSharedMemorySize, LDS_BYTES) != hipSuccess) { fprintf(stderr, "kernel_launch: hipFuncSetAttribute failed\n"); grid = -1; return; }
        if (hipOccupancyMaxActiveBlocksPerMultiprocessor(&per_cu, (const void*)mk_fwd, NWAVES * 64, LDS_BYTES) != hipSuccess || per_cu < 1) { fprintf(stderr, "kernel_launch: occupancy query says %d blocks per CU\n", per_cu); (void)hipGetLastError(); grid = -1; return; }
        grid = cus * per_cu;
    }
    if (grid < 0) return;
    Args a{};
    for (int i = 0; i < 12; ++i) a.in[i] = (const float*)d_in[i];
    a.out = (float*)d_out; a.ws = (unsigned char*)d_ws;
#if MK_N_LAUNCHES == 1
    a.ph_lo = 0; a.ph_hi = NPHASE;
    void* kargs[] = {&a};
    hipError_t e = hipLaunchCooperativeKernel((const void*)mk_fwd, dim3(grid), dim3(NWAVES * 64), kargs, LDS_BYTES, stream);
    if (e != hipSuccess) fprintf(stderr, "kernel_launch: cooperative launch failed: %s (grid %d)\n", hipGetErrorString(e), grid);
#else
    for (int p = 0; p < NPHASE; ++p) { a.ph_lo = p; a.ph_hi = p + 1; hipLaunchKernelGGL(mk_fwd, dim3(grid), dim3(NWAVES * 64), LDS_BYTES, stream, a); }
#endif
}
```

```cpp
#include <hip/hip_runtime.h>
#include <hip/hip_cooperative_groups.h>
#include <cstdio>
#include <cstdint>
namespace cg = cooperative_groups;
namespace pg8 {
#define PG8_LAS __attribute__((address_space(3)))
typedef unsigned short bf16_t;
typedef short bf16x8 __attribute__((ext_vector_type(8)));
typedef float f32x4 __attribute__((ext_vector_type(4)));
typedef unsigned u32x4 __attribute__((ext_vector_type(4)));
constexpr int BM = 256, BK = 64, HALF = 128, HTB = HALF * BK * 2  , STAGE_BYTES = 8 * HTB, NXCD = 8, WGM = 8;

__host__ __device__ __forceinline__ int lds_byte(int r, int c) { const int st = (r >> 4) * 2 + (c >> 5), rr = r & 15, cc = c & 31, ob = rr * 64 + cc * 2; return st * 1024 + (ob ^ (((ob >> 9) & 1) << 5)); }
__host__ __device__ __forceinline__ void stage_rc(int b, int& R, int& C) { const int st = b / 1024, sb = b % 1024, swz = sb ^ (((sb >> 9) & 1) << 5); R = (st >> 1) * 16 + swz / 64; C = (st & 1) * 32 + (swz % 64) / 2; }
__host__ __device__ __forceinline__ int perm32(int rho) { const int n = rho >> 4, i = rho & 15; return 8 * (i >> 2) + 4 * n + (i & 3); }

struct Unit { int pm, pn; };
struct Gemm { const bf16_t* A; const bf16_t* Bt; int M, N, K; };

struct StaticOrder {
    int nM, nN, nwg, G, c;
    __host__ __device__ void init(int M, int N, int G_, int c_) { nM = M / BM; nN = N / BM; nwg = nM * nN; G = G_; c = c_; }
    __host__ __device__ bool next(int i, Unit& u) const {
        const long L = (long)i * G + c; if (L >= nwg) return false;
        int wgid = (int)L; { const int q = nwg / NXCD, r = nwg % NXCD, xcd = wgid % NXCD, off = wgid / NXCD; wgid = (xcd < r ? xcd * (q + 1) : r * (q + 1) + (xcd - r) * q) + off; }
        const int nig = WGM * nN, gid = wgid / nig, fm = gid * WGM, gsz = (nM - fm) < WGM ? (nM - fm) : WGM;
        u.pm = fm + ((wgid % nig) % gsz); u.pn = (wgid % nig) / gsz; return true;
    }
    __device__ __forceinline__ void a_ready(const Unit&) const {}
    __device__ __forceinline__ void done(const Unit&) const {}
};

__device__ __forceinline__ unsigned cvt_pk_bf16(float lo, float hi) { unsigned r; asm volatile("v_cvt_pk_bf16_f32 %0, %1, %2" : "=v"(r) : "v"(lo), "v"(hi)); return r; }
typedef float f32x2 __attribute__((ext_vector_type(2)));
__device__ __forceinline__ f32x2 gelu_pk(f32x2 v) {
    const f32x2 av = __builtin_elementwise_abs(v), d = av * 0.2316418882f + 1.0f;
    f32x2 t; t.x = __builtin_amdgcn_rcpf(d.x); t.y = __builtin_amdgcn_rcpf(d.y);
    f32x2 q = t * 0.5307027145f + (-0.7265760135f); q = q * t + 0.7107068705f; q = q * t + (-0.142248368f); q = q * t + 0.127414796f; q = q * t;
    const f32x2 s = (v * v) * (-0.72134752044f);
    f32x2 e; e.x = __builtin_amdgcn_exp2f(s.x); e.y = __builtin_amdgcn_exp2f(s.y);
    const f32x2 m = v * (q * e), r = v - m;
    f32x2 o; o.x = v.x < 0.f ? m.x : r.x; o.y = v.y < 0.f ? m.y : r.y; return o;
}

template <int ACT  > struct EpiBf16 {
    static constexpr bool PERM = true, AFTER_DRAIN = false; static_assert(ACT == 0 || ACT == 1, "EpiBf16: ACT is 0 (none) or 1 (gelu_pk)");
    bf16_t* O; int ldc; const float* bias; int split_cols; size_t split_stride; float scale0;
    __device__ __forceinline__ void operator()(const f32x4 (&acc)[2][2][4][2], const Unit& u, int wr, int wc, int fr, int fq) const {
        const int row0 = u.pm * BM + wr * 64 + fr; int colt = u.pn * BM; bf16_t* base = O;
        float sc = 1.f; if (split_cols) { const int t = colt / split_cols; base += (size_t)t * split_stride; colt -= t * split_cols; if (t == 0) sc = scale0; }
        const int col0 = colt + wc * 32 + 8 * fq, bcol0 = u.pn * BM + wc * 32 + 8 * fq;
        f32x4 bv[2][2];
#pragma unroll
        for (int bj = 0; bj < 2; ++bj)
#pragma unroll
            for (int n = 0; n < 2; ++n) bv[bj][n] = bias ? *(const f32x4*)(bias + bcol0 + bj * HALF + 4 * n) : (f32x4){0.f, 0.f, 0.f, 0.f};
#pragma unroll
        for (int ai = 0; ai < 2; ++ai)
#pragma unroll
            for (int m = 0; m < 4; ++m) { bf16_t* rowp = base + (size_t)(row0 + ai * HALF + m * 16) * ldc + col0;
#pragma unroll
                for (int bj = 0; bj < 2; ++bj) { f32x4 v0 = acc[ai][bj][m][0] + bv[bj][0], v1 = acc[ai][bj][m][1] + bv[bj][1];
                    if (ACT == 1) { f32x2 a = gelu_pk((f32x2){v0[0], v0[1]}), b = gelu_pk((f32x2){v0[2], v0[3]}), c = gelu_pk((f32x2){v1[0], v1[1]}), d = gelu_pk((f32x2){v1[2], v1[3]});
                        v0 = (f32x4){a.x, a.y, b.x, b.y}; v1 = (f32x4){c.x, c.y, d.x, d.y}; }
                    v0 = v0 * sc; v1 = v1 * sc; u32x4 w; w.x = cvt_pk_bf16(v0[0], v0[1]); w.y = cvt_pk_bf16(v0[2], v0[3]); w.z = cvt_pk_bf16(v1[0], v1[1]); w.w = cvt_pk_bf16(v1[2], v1[3]);
                    *(u32x4*)(rowp + bj * HALF) = w; } }
    }
};
struct EpiY {
    static constexpr bool PERM = true, AFTER_DRAIN = false;
    bf16_t* Y; int ldc; float* ssq;
    __device__ __forceinline__ void operator()(const f32x4 (&acc)[2][2][4][2], const Unit& u, int wr, int wc, int fr, int fq) const {
        const int row0 = u.pm * BM + wr * 64 + fr; const int col0 = u.pn * BM + wc * 32 + 8 * fq;
#pragma unroll
        for (int ai = 0; ai < 2; ++ai)
#pragma unroll
            for (int m = 0; m < 4; ++m) { const int row = row0 + ai * HALF + m * 16; bf16_t* rowp = Y + (size_t)row * ldc + col0; float ss = 0.f;
#pragma unroll
                for (int bj = 0; bj < 2; ++bj) { const f32x4 v0 = acc[ai][bj][m][0], v1 = acc[ai][bj][m][1];
                    ss += (v0[0] * v0[0] + v0[1] * v0[1]) + (v0[2] * v0[2] + v0[3] * v0[3]) + (v1[0] * v1[0] + v1[1] * v1[1]) + (v1[2] * v1[2] + v1[3] * v1[3]);
                    u32x4 w; w.x = cvt_pk_bf16(v0[0], v0[1]); w.y = cvt_pk_bf16(v0[2], v0[3]); w.z = cvt_pk_bf16(v1[0], v1[1]); w.w = cvt_pk_bf16(v1[2], v1[3]);
                    *(u32x4*)(rowp + bj * HALF) = w; }
                ss += __shfl_xor(ss, 16); ss += __shfl_xor(ss, 32);
                if (fq == 0) ssq[(size_t)row * 32 + u.pn * 4 + wc] = ss; }
    }
};
template <class Epi, class Sched, bool ALIGN_EPI = false, bool SP2 = false>
__device__ __forceinline__ void gemm_phase(PG8_LAS unsigned char* lds, const Gemm g, const Sched& S, const Epi& E) {
    const int tid = threadIdx.x, wid = __builtin_amdgcn_readfirstlane(tid >> 6), lane = tid & 63, wr = wid >> 2, wc = wid & 3, fr = lane & 15, fq = lane >> 4;
    const int K = g.K, nt = K / BK;
    unsigned voffA[2], voffB[2];
#pragma unroll
    for (int i = 0; i < 2; ++i) { int R, C; stage_rc(tid * 16 + i * 8192, R, C); const int Rb = Epi::PERM ? ((R & ~31) + perm32(R & 31)) : R;
        voffA[i] = (unsigned)(R * K + C) * 2u; voffB[i] = (unsigned)(Rb * K + C) * 2u; }
    const size_t kstep = (size_t)(BK * 2);
    const size_t hstep = (size_t)HALF * K * 2;
    const size_t tstep = 2 * hstep;
    const unsigned ldsw = (unsigned)wid * 1024u;
    const int aoff = lds_byte(wr * 64 + fr, fq * 8), boff = lds_byte(wc * 32 + fr, fq * 8);
#define PG8_SA(b, h) (((b) * 2 + (h)) * HTB)
#define PG8_SB(b, h) ((4 + (b) * 2 + (h)) * HTB)
#define PG8_STAGE(bufoff, gbase, voff) do { _Pragma("unroll") for (int _i = 0; _i < 2; ++_i) \
        __builtin_amdgcn_global_load_lds((const unsigned*)((const char*)(gbase) + (voff)[_i]), (PG8_LAS unsigned*)(lds + (bufoff) + ldsw + _i * 8192), 16, 0, 0); } while (0)
#define PG8_LDA(dst, b, h) do { _Pragma("unroll") for (int m = 0; m < 4; ++m) _Pragma("unroll") for (int k = 0; k < 2; ++k) dst[m][k] = *(const PG8_LAS bf16x8*)(lds + PG8_SA(b, h) + aoff + m * 2048 + k * 1024); } while (0)
#define PG8_LDB(dst, b, h) do { _Pragma("unroll") for (int n = 0; n < 2; ++n) _Pragma("unroll") for (int k = 0; k < 2; ++k) dst[n][k] = *(const PG8_LAS bf16x8*)(lds + PG8_SB(b, h) + boff + n * 2048 + k * 1024); } while (0)
#define PG8_MMA(ai, bj, At, Bt) do { __builtin_amdgcn_s_setprio(1); _Pragma("unroll") for (int m = 0; m < 4; ++m) _Pragma("unroll") for (int n = 0; n < 2; ++n) _Pragma("unroll") for (int k = 0; k < 2; ++k) \
        acc[ai][bj][m][n] = __builtin_amdgcn_mfma_f32_16x16x32_bf16(Bt[n][k], At[m][k], acc[ai][bj][m][n], 0, 0, 0); __builtin_amdgcn_s_setprio(0); } while (0)
#define PG8_WAIT_V(n) asm volatile("s_waitcnt vmcnt(" #n ")" ::: "memory")
#define PG8_WAIT_L(n) asm volatile("s_waitcnt lgkmcnt(" #n ")" ::: "memory")
#define PG8_BAR __builtin_amdgcn_s_barrier()
#define PG8_SCHED __builtin_amdgcn_sched_barrier(0)
    Unit cur, nxt; int ui = 0;
    if (!S.next(0, cur)) return;
    f32x4 acc[2][2][4][2];
#pragma unroll
    for (int a = 0; a < 2; ++a)
#pragma unroll
        for (int b = 0; b < 2; ++b)
#pragma unroll
            for (int m = 0; m < 4; ++m)
#pragma unroll
                for (int n = 0; n < 2; ++n) acc[a][b][m][n] = (f32x4){0.f, 0.f, 0.f, 0.f};
    bf16x8 At[4][2], B0[2][2], B1[2][2];
    const char* cA = (const char*)g.A + (size_t)cur.pm * tstep; const char* cB = (const char*)g.Bt + (size_t)cur.pn * tstep;
    S.a_ready(cur);
    if constexpr (SP2) {
        PG8_STAGE(PG8_SB(0, 0), cB, voffB); PG8_STAGE(PG8_SB(0, 1), cB + hstep, voffB); PG8_STAGE(PG8_SA(0, 0), cA, voffA); PG8_STAGE(PG8_SA(0, 1), cA + hstep, voffA);
        if (wr == 1) PG8_BAR;
        PG8_WAIT_V(2); PG8_BAR;
        PG8_STAGE(PG8_SB(1, 0), cB + kstep, voffB); PG8_STAGE(PG8_SA(1, 0), cA + kstep, voffA); PG8_STAGE(PG8_SB(1, 1), cB + hstep + kstep, voffB);
        PG8_WAIT_V(6); PG8_BAR;
    } else {
        PG8_STAGE(PG8_SB(0, 0), cB, voffB); PG8_STAGE(PG8_SA(0, 0), cA, voffA); PG8_STAGE(PG8_SB(0, 1), cB + hstep, voffB); PG8_STAGE(PG8_SA(0, 1), cA + hstep, voffA);
        if (wr == 1) PG8_BAR;
        PG8_WAIT_V(4); PG8_BAR;
        PG8_STAGE(PG8_SB(1, 0), cB + kstep, voffB); PG8_STAGE(PG8_SA(1, 0), cA + kstep, voffA); PG8_STAGE(PG8_SB(1, 1), cB + hstep + kstep, voffB);
        PG8_WAIT_V(6); PG8_BAR;
    }
    for (;;) {
        const bool has_next = S.next(ui + 1, nxt);
        const char* nA = has_next ? (const char*)g.A + (size_t)nxt.pm * tstep : cA; const char* nB = has_next ? (const char*)g.Bt + (size_t)nxt.pn * tstep : cB;
        for (int t = 0; t < nt; t += 2) {
            const bool last = (t == nt - 2);
            const char* a1 = cA + (size_t)(t + 1) * kstep;
            const char* a2 = last ? nA : cA + (size_t)(t + 2) * kstep; const char* b2 = last ? nB : cB + (size_t)(t + 2) * kstep;
            const char* a3 = a2 + kstep; const char* b3 = b2 + kstep;
            if (last && has_next) S.a_ready(nxt);
            if constexpr (SP2) {
            PG8_LDB(B0, 0, 0); PG8_LDB(B1, 0, 1); PG8_SCHED; PG8_LDA(At, 0, 0); PG8_STAGE(PG8_SA(1, 1), a1 + hstep, voffA);
            PG8_WAIT_V(8); PG8_WAIT_L(0); PG8_BAR; PG8_MMA(0, 0, At, B0); PG8_MMA(0, 1, At, B1); PG8_BAR; PG8_SCHED;
            PG8_LDA(At, 0, 1); PG8_STAGE(PG8_SB(0, 0), b2, voffB); PG8_STAGE(PG8_SB(0, 1), b2 + hstep, voffB); PG8_STAGE(PG8_SA(0, 0), a2, voffA);
            PG8_WAIT_V(8); PG8_WAIT_L(0); PG8_BAR; PG8_MMA(1, 0, At, B0); PG8_MMA(1, 1, At, B1); PG8_BAR; PG8_SCHED;
            PG8_LDB(B0, 1, 0); PG8_LDB(B1, 1, 1); PG8_SCHED; PG8_LDA(At, 1, 0); PG8_STAGE(PG8_SA(0, 1), a2 + hstep, voffA);
            PG8_WAIT_V(8); PG8_WAIT_L(0); PG8_BAR; PG8_MMA(0, 0, At, B0); PG8_MMA(0, 1, At, B1); PG8_BAR; PG8_SCHED;
            PG8_LDA(At, 1, 1); PG8_STAGE(PG8_SB(1, 0), b3, voffB); PG8_STAGE(PG8_SB(1, 1), b3 + hstep, voffB); PG8_STAGE(PG8_SA(1, 0), a3, voffA);
            PG8_WAIT_V(8); PG8_WAIT_L(0); PG8_BAR; PG8_MMA(1, 0, At, B0); PG8_MMA(1, 1, At, B1); PG8_BAR; PG8_SCHED;
            } else {
            PG8_LDB(B0, 0, 0); PG8_SCHED; PG8_LDA(At, 0, 0); PG8_STAGE(PG8_SA(1, 1), a1 + hstep, voffA);
            PG8_WAIT_L(8); PG8_BAR; PG8_WAIT_L(0); PG8_MMA(0, 0, At, B0); PG8_BAR; PG8_SCHED;
            PG8_LDB(B1, 0, 1); PG8_STAGE(PG8_SB(0, 0), b2, voffB);
            PG8_BAR; PG8_WAIT_L(0); PG8_MMA(0, 1, At, B1); PG8_BAR;
            PG8_LDA(At, 0, 1); PG8_STAGE(PG8_SA(0, 0), a2, voffA);
            PG8_BAR; PG8_WAIT_L(0); PG8_MMA(1, 0, At, B0); PG8_BAR; PG8_SCHED;
            PG8_STAGE(PG8_SB(0, 1), b2 + hstep, voffB);
            PG8_WAIT_V(6); PG8_BAR; PG8_MMA(1, 1, At, B1); PG8_BAR;
            PG8_LDB(B0, 1, 0); PG8_SCHED; PG8_LDA(At, 1, 0); PG8_STAGE(PG8_SA(0, 1), a2 + hstep, voffA);
            PG8_WAIT_L(8); PG8_BAR; PG8_WAIT_L(0); PG8_MMA(0, 0, At, B0); PG8_BAR; PG8_SCHED;
            PG8_LDB(B1, 1, 1); PG8_STAGE(PG8_SB(1, 0), b3, voffB);
            PG8_BAR; PG8_WAIT_L(0); PG8_MMA(0, 1, At, B1); PG8_BAR;
            PG8_LDA(At, 1, 1); PG8_STAGE(PG8_SA(1, 0), a3, voffA);
            PG8_BAR; PG8_WAIT_L(0); PG8_MMA(1, 0, At, B0); PG8_BAR; PG8_SCHED;
            PG8_STAGE(PG8_SB(1, 1), b3 + hstep, voffB);
            PG8_WAIT_V(6); PG8_BAR; PG8_MMA(1, 1, At, B1); PG8_BAR;
            }
        }
        if constexpr (ALIGN_EPI) { if (wr == 0) PG8_BAR; }
        if constexpr (!Epi::AFTER_DRAIN) { E(acc, cur, wr, wc, fr, fq); S.done(cur); }
        if (!has_next) break;
#pragma unroll
        for (int a = 0; a < 2; ++a)
#pragma unroll
            for (int b = 0; b < 2; ++b)
#pragma unroll
                for (int m = 0; m < 4; ++m)
#pragma unroll
                    for (int n = 0; n < 2; ++n) acc[a][b][m][n] = (f32x4){0.f, 0.f, 0.f, 0.f};
        cur = nxt; cA = nA; cB = nB; ++ui;
        if constexpr (ALIGN_EPI) { if (wr == 1) PG8_BAR; }
    }
    PG8_WAIT_V(0);
    if constexpr (!ALIGN_EPI) { if (wr == 0) PG8_BAR; }
    PG8_BAR;
    if constexpr (Epi::AFTER_DRAIN) { E.fused(acc, cur, wr, wc, fr, fq, lds, wid, lane); S.done(cur); }
#undef PG8_SA
#undef PG8_SB
#undef PG8_STAGE
#undef PG8_LDA
#undef PG8_LDB
#undef PG8_MMA
#undef PG8_WAIT_V
#undef PG8_WAIT_L
#undef PG8_BAR
#undef PG8_SCHED
}
}

#ifndef PG8_SP2
#define PG8_SP2 true
#endif
#ifndef PG8_ALIGN
#define PG8_ALIGN true
#endif
#ifndef MK_N_LAUNCHES
#define MK_N_LAUNCHES 1
#endif
#ifndef ATTN_NAIVE
#define ATTN_NAIVE 0
#endif

using pg8::bf16_t; using pg8::bf16x8; using pg8::f32x4; using pg8::u32x4;
typedef unsigned u32x2 __attribute__((ext_vector_type(2)));
typedef float f32x2 __attribute__((ext_vector_type(2)));
#define LAS __attribute__((address_space(3)))
constexpr int BATCH = 8, SEQ = 2048, DM = 2048, MTOK = BATCH * SEQ, NPROJ = 8192, DG = 1024, NH = 16, HD = 64, NMOD = 3 * DM;
constexpr int OFF_U = 0, OFF_B = 1024, OFF_C = 2048, OFF_ZC = 3072, OFF_Q = 4096, OFF_K = 5120, OFF_V = 6144, OFF_ZA = 7168;
constexpr float EPS = 1e-6f, LOG2E = 1.4426950408889634f;
constexpr int KSPLIT = 16, NWAVES = 8, NPHASE = 7;
constexpr size_t MiB = 1u << 20;
constexpr size_t WS_MODP = 1 * MiB, WS_GATE = 4 * MiB, WS_SSQA = 5 * MiB, WS_SSQY = 6 * MiB, WS_WOUTT = 8 * MiB, WS_WINT = 16 * MiB, WS_O = 48 * MiB,
                 WS_H = 80 * MiB, WS_YCAT = WS_H  , WS_PROJ = 144 * MiB, WS_Y = WS_PROJ  , WS_END = 400 * MiB;
constexpr int LDS_BYTES = 147456;

#define LDS_WAIT() asm volatile("s_waitcnt lgkmcnt(0)" ::: "memory")
__device__ __forceinline__ float bf_lo(unsigned u) { return __uint_as_float(u << 16); }
__device__ __forceinline__ float bf_hi(unsigned u) { return __uint_as_float(u & 0xffff0000u); }
__device__ __forceinline__ unsigned pk(float lo, float hi) { return pg8::cvt_pk_bf16(lo, hi); }
__device__ __forceinline__ float silu_f(float v) { return v * __builtin_amdgcn_rcpf(1.f + __builtin_amdgcn_exp2f(-v * LOG2E)); }
__device__ __forceinline__ float wave_sum(float v) {
#pragma unroll
    for (int o = 1; o < 64; o <<= 1) v += __shfl_xor(v, o);
    return v;
}
__device__ __forceinline__ void unpack8(const u32x4 w, float* f) { f[0] = bf_lo(w.x); f[1] = bf_hi(w.x); f[2] = bf_lo(w.y); f[3] = bf_hi(w.y); f[4] = bf_lo(w.z); f[5] = bf_hi(w.z); f[6] = bf_lo(w.w); f[7] = bf_hi(w.w); }
__device__ __forceinline__ void load16(const bf16_t* rowp, int lane, float (&f)[16]) {
    const u32x4 a = *(const u32x4*)(rowp + 8 * lane), b = *(const u32x4*)(rowp + 512 + 8 * lane); unpack8(a, f); unpack8(b, f + 8);
}
__device__ __forceinline__ void load16f(const float* p, int lane, float (&f)[16]) {
#pragma unroll
    for (int j = 0; j < 2; ++j) { const f32x4 a = *(const f32x4*)(p + 512 * j + 8 * lane), b = *(const f32x4*)(p + 512 * j + 8 * lane + 4);
        f[8 * j + 0] = a[0]; f[8 * j + 1] = a[1]; f[8 * j + 2] = a[2]; f[8 * j + 3] = a[3]; f[8 * j + 4] = b[0]; f[8 * j + 5] = b[1]; f[8 * j + 6] = b[2]; f[8 * j + 7] = b[3]; }
}
__device__ __forceinline__ void store16(bf16_t* rowp, int lane, const float (&y)[16]) {
#pragma unroll
    for (int j = 0; j < 2; ++j) { u32x4 w; w.x = pk(y[8 * j + 0], y[8 * j + 1]); w.y = pk(y[8 * j + 2], y[8 * j + 3]); w.z = pk(y[8 * j + 4], y[8 * j + 5]); w.w = pk(y[8 * j + 6], y[8 * j + 7]);
        *(u32x4*)(rowp + 512 * j + 8 * lane) = w; }
}

__device__ __forceinline__ void p0_transpose_item(const float* __restrict__ W, int K, int N, bf16_t* __restrict__ WT, LAS float* scr, int item, int lane) {
    const int nblk = N / 32, kb = item / nblk, nb = item % nblk, k0 = 64 * kb, n0 = 32 * nb;
#pragma unroll 8
    for (int i = 0; i < 32; ++i) { const int kk = 2 * i + (lane >> 5); scr[kk * 33 + (lane & 31)] = W[(size_t)(k0 + kk) * N + n0 + (lane & 31)]; }
    LDS_WAIT();
    const int c = lane & 7;
#pragma unroll
    for (int j = 0; j < 4; ++j) { const int n = (lane >> 3) + 8 * j; const LAS float* s = scr + (8 * c) * 33 + n;
        u32x4 o; o.x = pk(s[0 * 33], s[1 * 33]); o.y = pk(s[2 * 33], s[3 * 33]); o.z = pk(s[4 * 33], s[5 * 33]); o.w = pk(s[6 * 33], s[7 * 33]);
        *(u32x4*)(WT + (size_t)(n0 + n) * K + k0 + 8 * c) = o; }
    LDS_WAIT();
}
__device__ __forceinline__ void p0_mod_item(const float* __restrict__ cvec, const float* __restrict__ wada, float* __restrict__ modp, LAS float* scr, int item, int lane) {
    const int kc = item / 48, nc = item % 48, k0 = kc * 128, n0 = nc * 128;
#pragma unroll
    for (int i = 0; i < 16; ++i) { const int idx = i * 64 + lane, b = idx >> 7, kk = idx & 127; scr[kk * 8 + b] = silu_f(cvec[b * DM + k0 + kk]); }
    LDS_WAIT();
    float acc[8][2];
#pragma unroll
    for (int b = 0; b < 8; ++b) { acc[b][0] = 0.f; acc[b][1] = 0.f; }
    const float* wp = wada + (size_t)k0 * NMOD + n0 + 2 * lane;
#pragma unroll 8
    for (int kk = 0; kk < 128; ++kk) {
        const f32x2 w = *(const f32x2*)(wp + (size_t)kk * NMOD);
        const f32x4 s0 = *(const LAS f32x4*)(scr + kk * 8), s1 = *(const LAS f32x4*)(scr + kk * 8 + 4);
        acc[0][0] += s0[0] * w[0]; acc[0][1] += s0[0] * w[1]; acc[1][0] += s0[1] * w[0]; acc[1][1] += s0[1] * w[1];
        acc[2][0] += s0[2] * w[0]; acc[2][1] += s0[2] * w[1]; acc[3][0] += s0[3] * w[0]; acc[3][1] += s0[3] * w[1];
        acc[4][0] += s1[0] * w[0]; acc[4][1] += s1[0] * w[1]; acc[5][0] += s1[1] * w[0]; acc[5][1] += s1[1] * w[1];
        acc[6][0] += s1[2] * w[0]; acc[6][1] += s1[2] * w[1]; acc[7][0] += s1[3] * w[0]; acc[7][1] += s1[3] * w[1];
    }
#pragma unroll
    for (int b = 0; b < 8; ++b) *(f32x2*)(modp + ((size_t)kc * 8 + b) * NMOD + n0 + 2 * lane) = (f32x2){acc[b][0], acc[b][1]};
    LDS_WAIT();
}

__device__ __forceinline__ void p1_rows(const float* __restrict__ x, const float* __restrict__ b_ada, const float* __restrict__ g_pre, const float* __restrict__ modp,
                                        float* __restrict__ gate, bf16_t* __restrict__ hbuf, LAS unsigned char* lds, int bx, int G, int tid, int wave, int lane) {
    LAS float* Ac = (LAS float*)lds; LAS float* Sc = Ac + DM;
    for (int chunk = bx; chunk < MTOK / 64; chunk += G) {
        const int b = chunk >> 5;
        __syncthreads();
        { const int d = tid * 4;
          f32x4 sh = *(const f32x4*)(b_ada + d), sc = *(const f32x4*)(b_ada + DM + d);
#pragma unroll 4
          for (int kc = 0; kc < KSPLIT; ++kc) { const float* p = modp + ((size_t)kc * 8 + b) * NMOD + d; sh += *(const f32x4*)p; sc += *(const f32x4*)(p + DM); }
          const f32x4 g = *(const f32x4*)(g_pre + d);
          *(LAS f32x4*)(Ac + d) = g * (sc + 1.0f); *(LAS f32x4*)(Sc + d) = sh;
          if ((chunk & 31) == 0) { f32x4 gt = *(const f32x4*)(b_ada + 2 * DM + d);
#pragma unroll 4
              for (int kc = 0; kc < KSPLIT; ++kc) gt += *(const f32x4*)(modp + ((size_t)kc * 8 + b) * NMOD + 2 * DM + d);
              *(f32x4*)(gate + b * DM + d) = gt; } }
        __syncthreads();
        for (int i = 0; i < 8; ++i) {
            const int row = chunk * 64 + wave * 8 + i;
            const f32x4* xr = (const f32x4*)(x + (size_t)row * DM) + lane;
            f32x4 v[8]; float s = 0.f;
#pragma unroll
            for (int j = 0; j < 8; ++j) { v[j] = xr[64 * j]; s += (v[j][0] * v[j][0] + v[j][1] * v[j][1]) + (v[j][2] * v[j][2] + v[j][3] * v[j][3]); }
            const float rstd = 1.0f / sqrtf(wave_sum(s) * (1.0f / DM) + EPS);
            u32x2* o8 = (u32x2*)(hbuf + (size_t)row * DM) + lane;
#pragma unroll
            for (int j = 0; j < 8; ++j) { const int d = 4 * lane + 256 * j; const f32x4 a = *(const LAS f32x4*)(Ac + d), sft = *(const LAS f32x4*)(Sc + d);
                const f32x4 o = v[j] * rstd * a + sft; u32x2 w; w.x = pk(o[0], o[1]); w.y = pk(o[2], o[3]); o8[64 * j] = w; }
        }
    }
}

__device__ __forceinline__ void conv_unit(const bf16_t* __restrict__ proj, const float* __restrict__ cw, const float* __restrict__ cb, const float* __restrict__ gc,
                                          bf16_t* __restrict__ ycat, int unit, int wave, int lane) {
    const int tk0 = unit * 64 + wave * 8, t0 = tk0 & (SEQ - 1);
    float w0[16], w1[16], w2[16], bb[16];
    load16f(cw, lane, w0); load16f(cw + DG, lane, w1); load16f(cw + 2 * DG, lane, w2); load16f(cb, lane, bb);
    float pp[16], pc[16], pn[16], ta[16], tb[16];
    const bf16_t* base = proj + (size_t)tk0 * NPROJ;
    if (t0 > 0) { load16(base - NPROJ + OFF_C, lane, ta); load16(base - NPROJ + OFF_U, lane, tb);
#pragma unroll
        for (int e = 0; e < 16; ++e) pp[e] = ta[e] * tb[e]; }
    else {
#pragma unroll
        for (int e = 0; e < 16; ++e) pp[e] = 0.f; }
    load16(base + OFF_C, lane, ta); load16(base + OFF_U, lane, tb);
#pragma unroll
    for (int e = 0; e < 16; ++e) pc[e] = ta[e] * tb[e];
#pragma unroll 1
    for (int i = 0; i < 8; ++i) {
        const bf16_t* rp = base + (size_t)i * NPROJ;
        if (t0 + i + 1 < SEQ) { load16(rp + NPROJ + OFF_C, lane, ta); load16(rp + NPROJ + OFF_U, lane, tb);
#pragma unroll
            for (int e = 0; e < 16; ++e) pn[e] = ta[e] * tb[e]; }
        else {
#pragma unroll
            for (int e = 0; e < 16; ++e) pn[e] = 0.f; }
        load16(rp + OFF_B, lane, ta); load16(rp + OFF_ZC, lane, tb);
        float v[16], ss = 0.f;
#pragma unroll
        for (int e = 0; e < 16; ++e) { v[e] = ta[e] * (w0[e] * pp[e] + w1[e] * pc[e] + w2[e] * pn[e] + bb[e]); ss += v[e] * v[e]; }
        const float rstd = 1.0f / sqrtf(wave_sum(ss) * (1.0f / DG) + EPS);
        float g[16]; load16f(gc, lane, g);
#pragma unroll
        for (int e = 0; e < 16; ++e) v[e] = v[e] * rstd * g[e] * silu_f(tb[e]);
        store16(ycat + (size_t)(tk0 + i) * DM, lane, v);
#pragma unroll
        for (int e = 0; e < 16; ++e) { pp[e] = pc[e]; pc[e] = pn[e]; }
    }
}

#if ATTN_NAIVE
__device__ __forceinline__ void attn_naive_item(const bf16_t* __restrict__ proj, bf16_t* __restrict__ obuf, float* __restrict__ ssqa, int item, int tid) {
    const int bh = item >> 2, b = bh >> 4, h = bh & 15, t = (item & 3) * 512 + tid;
    const size_t tokb = (size_t)b * SEQ;
    float q[64], O[64];
    { const u32x4* qp = (const u32x4*)(proj + (tokb + t) * NPROJ + OFF_Q + h * HD);
#pragma unroll
      for (int i = 0; i < 8; ++i) { const u32x4 w = qp[i]; unpack8(w, q + 8 * i); } }
#pragma unroll
    for (int d = 0; d < 64; ++d) O[d] = 0.f;
    float M = -1e30f, Ls = 0.f;
    const float slope = exp2f(-0.5f * (float)(h + 1));
    for (int br = 0; br < 3; ++br) {
        const int R = br == 0 ? 1 : (br == 1 ? 4 : 16); const float sr = slope * (float)R;
        for (int j = -64; j <= 64; ++j) {
            const int pos = t + R * j; if (pos < 0 || pos >= SEQ) continue;
            const u32x4* kp = (const u32x4*)(proj + (tokb + pos) * NPROJ + OFF_K + h * HD); const u32x4* vp = (const u32x4*)(proj + (tokb + pos) * NPROJ + OFF_V + h * HD);
            float dot = 0.f;
#pragma unroll
            for (int i = 0; i < 8; ++i) { const u32x4 w = kp[i]; float kf[8]; unpack8(w, kf);
#pragma unroll
                for (int e = 0; e < 8; ++e) dot += q[8 * i + e] * kf[e]; }
            const float s = dot * 0.125f - sr * fabsf((float)j);
            const float mn = fmaxf(M, s), a = __expf(M - mn), p = __expf(s - mn); Ls = Ls * a + p; M = mn;
#pragma unroll
            for (int i = 0; i < 8; ++i) { const u32x4 w = vp[i]; float vf[8]; unpack8(w, vf);
#pragma unroll
                for (int e = 0; e < 8; ++e) O[8 * i + e] = O[8 * i + e] * a + p * vf[e]; }
        }
    }
    const float inv = 1.0f / Ls; float ss = 0.f;
    u32x4* op = (u32x4*)(obuf + (tokb + t) * DG + h * HD);
#pragma unroll
    for (int i = 0; i < 8; ++i) { float o[8];
#pragma unroll
        for (int e = 0; e < 8; ++e) { o[e] = O[8 * i + e] * inv; ss += o[e] * o[e]; }
        u32x4 w; w.x = pk(o[0], o[1]); w.y = pk(o[2], o[3]); w.z = pk(o[4], o[5]); w.w = pk(o[6], o[7]); op[i] = w; }
    ssqa[(tokb + t) * NH + h] = ss;
}
constexpr int NATT = BATCH * NH * 4;
#else
namespace att {
constexpr int OST = 68;
constexpr int LDS_O = 0, LDS_ML = 256 * OST * 4, LDS_V = LDS_ML + 2048, VROW = 144, VWAVE = 32 * VROW;
static_assert(LDS_V + NWAVES * VWAVE <= LDS_BYTES, "attention LDS map");
typedef short v4i16_t __attribute__((ext_vector_type(4)));
__device__ __forceinline__ v4i16_t vtr(LAS unsigned char* p) { return __builtin_amdgcn_ds_read_tr16_b64_v4i16((LAS v4i16_t*)p); }
#define CFENCE() asm volatile("" ::: "memory")

template <int R, bool FIRST>
__device__ __forceinline__ void branch_unit(const bf16_t* __restrict__ proj, size_t tokb, int h, int P0, int Gi, float sl2  , LAS unsigned char* lds, int wave, int lane) {
    constexpr int L = SEQ / R;
    asm volatile("" : "+v"(lane));
    const int q = lane & 15, quad = lane >> 4;
    const int rho = Gi % R, gi = Gi / R, I0 = P0 / R + 16 * gi;
    const bf16_t* hb = proj + tokb * NPROJ + h * HD;
    const bf16_t* vb = hb + OFF_V + 8 * (lane & 7);
    u32x4 vcur[4], vnxt[4];
    const bf16_t* qp = hb + (size_t)(rho + R * (I0 + q)) * NPROJ + OFF_Q + 8 * quad;
    const bf16x8 qf0 = *(const bf16x8*)qp, qf1 = *(const bf16x8*)(qp + 32);
    f32x4 s[5][2];
    bf16x8 kc[4], kn[4];
#define LOADK(dst, tau_) do { _Pragma("unroll") for (int hf = 0; hf < 2; ++hf) { int Ik = I0 - 64 + 32 * (tau_) + 16 * hf + q; Ik = Ik < 0 ? 0 : (Ik > L - 1 ? L - 1 : Ik); \
        const bf16_t* kp = hb + (size_t)(rho + R * Ik) * NPROJ + OFF_K + 8 * quad; dst[2 * hf] = *(const bf16x8*)kp; dst[2 * hf + 1] = *(const bf16x8*)(kp + 32); } } while (0)
    LOADK(kc, 0);
#pragma unroll
    for (int tau = 0; tau < 5; ++tau) {
        if (tau < 4) LOADK(kn, tau + 1);
        else {
#pragma unroll
            for (int it = 0; it < 4; ++it) { int Ik = I0 - 64 + (lane >> 3) + 8 * it; Ik = Ik < 0 ? 0 : (Ik > L - 1 ? L - 1 : Ik); vcur[it] = *(const u32x4*)(vb + (size_t)(rho + R * Ik) * NPROJ); }
        }
#pragma unroll
        for (int hf = 0; hf < 2; ++hf) { f32x4 acc = (f32x4){0.f, 0.f, 0.f, 0.f};
            acc = __builtin_amdgcn_mfma_f32_16x16x32_bf16(kc[2 * hf], qf0, acc, 0, 0, 0);
            acc = __builtin_amdgcn_mfma_f32_16x16x32_bf16(kc[2 * hf + 1], qf1, acc, 0, 0, 0);
            s[tau][hf] = acc; }
        if (tau < 4) {
#pragma unroll
            for (int j = 0; j < 4; ++j) kc[j] = kn[j];
        }
        __builtin_amdgcn_sched_barrier(0);
    }
#undef LOADK
    const float relb = (float)(4 * quad - 64 - q); const int ikb = I0 - 64 + 4 * quad; const float c1 = 0.125f * LOG2E;
    float m = -1e30f;
#pragma unroll
    for (int tau = 0; tau < 5; ++tau)
#pragma unroll
        for (int hf = 0; hf < 2; ++hf)
#pragma unroll
            for (int i = 0; i < 4; ++i) { const int kc = 32 * tau + 16 * hf + i; const float rel = relb + (float)kc, arel = fabsf(rel); const int Ik = ikb + kc;
                const bool ok = (arel <= 64.f) && ((unsigned)Ik < (unsigned)L);
                float v = s[tau][hf][i] * c1 - sl2 * arel; v = ok ? v : -1e30f; s[tau][hf][i] = v; m = fmaxf(m, v); }
    m = fmaxf(m, __shfl_xor(m, 16)); m = fmaxf(m, __shfl_xor(m, 32));
    float lsum = 0.f; bf16x8 pb[5];
#pragma unroll
    for (int tau = 0; tau < 5; ++tau) { float p[8];
#pragma unroll
        for (int i = 0; i < 4; ++i) { p[i] = __builtin_amdgcn_exp2f(s[tau][0][i] - m); p[4 + i] = __builtin_amdgcn_exp2f(s[tau][1][i] - m); }
        lsum += ((p[0] + p[1]) + (p[2] + p[3])) + ((p[4] + p[5]) + (p[6] + p[7]));
        u32x4 w; w.x = pk(p[0], p[1]); w.y = pk(p[2], p[3]); w.z = pk(p[4], p[5]); w.w = pk(p[6], p[7]); pb[tau] = __builtin_bit_cast(bf16x8, w); }
    f32x4 o[4];
#pragma unroll
    for (int c = 0; c < 4; ++c) o[c] = (f32x4){0.f, 0.f, 0.f, 0.f};
    LAS unsigned char* vst = lds + LDS_V + wave * VWAVE;
    LAS unsigned char* vwr = vst + (lane >> 3) * VROW + (lane & 7) * 16;
    LAS unsigned char* vrd = vst + (4 * quad + (q >> 2)) * VROW + 8 * (q & 3);
#pragma unroll
    for (int tau = 0; tau < 5; ++tau) {
        if (tau < 4) {
#pragma unroll
            for (int it = 0; it < 4; ++it) { int Ik = I0 - 64 + 32 * (tau + 1) + (lane >> 3) + 8 * it; Ik = Ik < 0 ? 0 : (Ik > L - 1 ? L - 1 : Ik); vnxt[it] = *(const u32x4*)(vb + (size_t)(rho + R * Ik) * NPROJ); }
        }
#pragma unroll
        for (int it = 0; it < 4; ++it) *(LAS u32x4*)(vwr + 8 * it * VROW) = vcur[it];
        LDS_WAIT();
#pragma unroll
        for (int c = 0; c < 4; ++c) { const v4i16_t lo = vtr(vrd + 32 * c), hi = vtr(vrd + 16 * VROW + 32 * c);
            const bf16x8 a = (bf16x8){lo[0], lo[1], lo[2], lo[3], hi[0], hi[1], hi[2], hi[3]};
            o[c] = __builtin_amdgcn_mfma_f32_16x16x32_bf16(a, pb[tau], o[c], 0, 0, 0); }
        LDS_WAIT();
        if (tau < 4) {
#pragma unroll
            for (int it = 0; it < 4; ++it) vcur[it] = vnxt[it];
        }
    }
    float l = lsum + __shfl_xor(lsum, 16); l += __shfl_xor(l, 32);
    const int ql = rho + R * (16 * gi + q);
    LAS float* Or = (LAS float*)(lds + LDS_O) + ql * OST + 4 * quad;
    LAS float* ML = (LAS float*)(lds + LDS_ML) + 2 * ql;
    if (FIRST) {
#pragma unroll
        for (int c = 0; c < 4; ++c) *(LAS f32x4*)(Or + 16 * c) = o[c];
        if (quad == 0) { ML[0] = m; ML[1] = l; }
    } else {
        const float Mo = ML[0], Lo = ML[1]; const float mn = fmaxf(Mo, m), a = __builtin_amdgcn_exp2f(Mo - mn), bs = __builtin_amdgcn_exp2f(m - mn);
#pragma unroll
        for (int c = 0; c < 4; ++c) { const f32x4 t = *(LAS f32x4*)(Or + 16 * c); *(LAS f32x4*)(Or + 16 * c) = t * a + o[c] * bs; }
        LDS_WAIT();
        if (quad == 0) { ML[0] = mn; ML[1] = Lo * a + l * bs; }
    }
}

__device__ __forceinline__ void attn_final(bf16_t* __restrict__ obuf, float* __restrict__ ssqa, size_t tokb, int h, int P0, LAS unsigned char* lds, int wave, int lane) {
#pragma unroll
    for (int it = 0; it < 4; ++it) { const int row = 32 * wave + (lane >> 3) + 8 * it, ch = lane & 7;
        LAS float* Or = (LAS float*)(lds + LDS_O) + row * OST + 8 * ch; f32x4 a = *(LAS f32x4*)Or, b = *(LAS f32x4*)(Or + 4);
        const float inv = 1.0f / ((LAS float*)(lds + LDS_ML))[2 * row + 1];
        a = a * inv; b = b * inv;
        float ss = ((a[0] * a[0] + a[1] * a[1]) + (a[2] * a[2] + a[3] * a[3])) + ((b[0] * b[0] + b[1] * b[1]) + (b[2] * b[2] + b[3] * b[3]));
        u32x4 w; w.x = pk(a[0], a[1]); w.y = pk(a[2], a[3]); w.z = pk(b[0], b[1]); w.w = pk(b[2], b[3]);
        *(u32x4*)(obuf + (tokb + P0 + row) * DG + h * HD + 8 * ch) = w;
        ss += __shfl_xor(ss, 1); ss += __shfl_xor(ss, 2); ss += __shfl_xor(ss, 4);
        if (ch == 0) ssqa[(tokb + P0 + row) * NH + h] = ss; }
}
}
constexpr int NATT = BATCH * NH * 8;
__device__ __forceinline__ void attn_unit(const bf16_t* __restrict__ proj, bf16_t* __restrict__ obuf, float* __restrict__ ssqa, LAS unsigned char* lds, int item, int wave, int lane) {
    const int bh = item >> 3, qb = item & 7, b = bh >> 4, h = bh & 15, P0 = qb * 256;
    const size_t tokb = (size_t)b * SEQ;
    const float sl2 = exp2f(-0.5f * (float)(h + 1)) * LOG2E;
#pragma unroll 1
    for (int g2 = 0; g2 < 2; ++g2) att::branch_unit<1, true>(proj, tokb, h, P0, wave + 8 * g2, sl2, lds, wave, lane);
    __syncthreads();
#pragma unroll 1
    for (int g2 = 0; g2 < 2; ++g2) att::branch_unit<4, false>(proj, tokb, h, P0, wave + 8 * g2, sl2 * 4.f, lds, wave, lane);
    __syncthreads();
#pragma unroll 1
    for (int g2 = 0; g2 < 2; ++g2) att::branch_unit<16, false>(proj, tokb, h, P0, wave + 8 * g2, sl2 * 16.f, lds, wave, lane);
    __syncthreads();
    att::attn_final(obuf, ssqa, tokb, h, P0, lds, wave, lane);
    __syncthreads();
}

#endif

struct Args { const float* in[12]; float* out; unsigned char* ws; int ph_lo, ph_hi; };
__global__ void __launch_bounds__(NWAVES * 64, 2) mk_fwd(Args args) {
    extern __shared__ __attribute__((aligned(16))) unsigned char lds_raw[];
    LAS unsigned char* lds = (LAS unsigned char*)lds_raw;
    const int tid = threadIdx.x, lane = tid & 63, wave = __builtin_amdgcn_readfirstlane(tid >> 6);
    const int G = gridDim.x, bx = blockIdx.x, vcu = (G % 8 == 0) ? (bx % 8) * (G / 8) + bx / 8 : bx;
    const float *x = args.in[0], *cvec = args.in[1], *w_ada = args.in[2], *b_ada = args.in[3], *g_pre = args.in[4], *w_in = args.in[5], *conv_w = args.in[6], *conv_b = args.in[7],
                *g_conv = args.in[8], *g_attn = args.in[9], *w_out = args.in[10], *g_post = args.in[11];
    unsigned char* ws = args.ws;
    float* modp = (float*)(ws + WS_MODP); float* gate = (float*)(ws + WS_GATE); float* ssqa = (float*)(ws + WS_SSQA); float* ssqy = (float*)(ws + WS_SSQY);
    bf16_t* woutT = (bf16_t*)(ws + WS_WOUTT); bf16_t* winT = (bf16_t*)(ws + WS_WINT); bf16_t* obuf = (bf16_t*)(ws + WS_O); bf16_t* hbuf = (bf16_t*)(ws + WS_H);
    bf16_t* ycat = (bf16_t*)(ws + WS_YCAT); bf16_t* proj = (bf16_t*)(ws + WS_PROJ); bf16_t* ybuf = (bf16_t*)(ws + WS_Y);
    const int lo = args.ph_lo, hi = args.ph_hi;
    const int gw = bx * NWAVES + wave, NGW = G * NWAVES;
#define IN(k) (lo <= (k) && (k) < hi)
#define SEAM(k) do { if (IN(k) && IN((k) + 1)) { cg::this_grid().sync(); } } while (0)

    if (IN(0)) {
        LAS float* scr = (LAS float*)(lds + wave * 16384);
        constexpr int I_MOD = KSPLIT * 48, I_IN = (DM / 64) * (NPROJ / 32), I_OUT = (DM / 64) * (DM / 32);
        for (int it = gw; it < I_MOD + I_IN + I_OUT; it += NGW) {
            if (it < I_MOD) p0_mod_item(cvec, w_ada, modp, scr, it, lane);
            else if (it < I_MOD + I_IN) p0_transpose_item(w_in, DM, NPROJ, winT, scr, it - I_MOD, lane);
            else p0_transpose_item(w_out, DM, DM, woutT, scr, it - I_MOD - I_IN, lane);
        }
    }
    SEAM(0);
    if (IN(1)) p1_rows(x, b_ada, g_pre, modp, gate, hbuf, lds, bx, G, tid, wave, lane);
    SEAM(1);
    if (IN(2)) {
        pg8::Gemm g{hbuf, winT, MTOK, NPROJ, DM}; pg8::StaticOrder S; S.init(MTOK, NPROJ, G, bx);
        pg8::EpiBf16<0> E{proj, NPROJ, nullptr, 0, 0, 1.f};
        pg8::gemm_phase<pg8::EpiBf16<0>, pg8::StaticOrder, PG8_ALIGN, PG8_SP2>(lds, g, S, E);
    }
    SEAM(2);
    if (IN(3)) {
        for (int it = vcu; it < NATT + MTOK / 64; it += G) {
            if (it < NATT) {
#if ATTN_NAIVE
                attn_naive_item(proj, obuf, ssqa, it, tid);
#else
                attn_unit(proj, obuf, ssqa, lds, it, wave, lane);
#endif
            } else conv_unit(proj, conv_w, conv_b, g_conv, ycat, it - NATT, wave, lane);
        }
    }
    SEAM(3);
    if (IN(4)) {
        for (int row = gw; row < MTOK; row += NGW) {
            const float sv = lane < NH ? ssqa[(size_t)row * NH + lane] : 0.f;
            const float rstd = 1.0f / sqrtf(wave_sum(sv) * (1.0f / DG) + EPS);
            float ov[16], zv[16], g[16];
            load16(obuf + (size_t)row * DG, lane, ov); load16(proj + (size_t)row * NPROJ + OFF_ZA, lane, zv); load16f(g_attn, lane, g);
#pragma unroll
            for (int e = 0; e < 16; ++e) ov[e] = ov[e] * rstd * g[e] * silu_f(zv[e]);
            store16(ycat + (size_t)row * DM + DG, lane, ov);
        }
    }
    SEAM(4);
    if (IN(5)) {
        pg8::Gemm g{ycat, woutT, MTOK, DM, DM}; pg8::StaticOrder S; S.init(MTOK, DM, G, bx);
        pg8::EpiY E{ybuf, DM, ssqy};
        pg8::gemm_phase<pg8::EpiY, pg8::StaticOrder, PG8_ALIGN, PG8_SP2>(lds, g, S, E);
    }
    SEAM(5);
    if (IN(6)) {
        for (int row = gw; row < MTOK; row += NGW) {
            const int b = row >> 11;
            const float sv = lane < 32 ? ssqy[(size_t)row * 32 + lane] : 0.f;
            const float rstd = 1.0f / sqrtf(wave_sum(sv) * (1.0f / DM) + EPS);
#pragma unroll
            for (int j = 0; j < 4; ++j) { const int c = 512 * j + 8 * lane; const size_t off = (size_t)row * DM + c;
                const u32x4 yw = *(const u32x4*)(ybuf + off); float yv[8]; unpack8(yw, yv);
                const f32x4 x0 = *(const f32x4*)(x + off), x1 = *(const f32x4*)(x + off + 4), g0 = *(const f32x4*)(gate + b * DM + c), g1 = *(const f32x4*)(gate + b * DM + c + 4),
                            p0 = *(const f32x4*)(g_post + c), p1 = *(const f32x4*)(g_post + c + 4);
                f32x4 o0, o1;
#pragma unroll
                for (int e = 0; e < 4; ++e) { o0[e] = x0[e] + g0[e] * p0[e] * (yv[e] * rstd); o1[e] = x1[e] + g1[e] * p1[e] * (yv[4 + e] * rstd); }
                *(f32x4*)(args.out + off) = o0; *(f32x4*)(args.out + off + 4) = o1; }
        }
    }
#undef IN
#undef SEAM
}

extern "C" void kernel_launch(void* const* d_in, const int* in_sizes, int n_in, void* d_out, int out_size, void* d_ws, size_t ws_size, hipStream_t stream) {
    static int grid = 0;
    if (grid == 0) {
        if (n_in != 12 || in_sizes[0] != MTOK * DM || out_size != MTOK * DM || ws_size < WS_END) { fprintf(stderr, "kernel_launch: unexpected problem (n_in %d, in0 %d, out %d, ws %zu); nothing launched\n", n_in, n_in > 0 ? in_sizes[0] : -1, out_size, ws_size); grid = -1; return; }
        int dev = 0, cus = 0, per_cu = 0;
        if (hipGetDevice(&dev) != hipSuccess || hipDeviceGetAttribute(&cus, hipDeviceAttributeMultiprocessorCount, dev) != hipSuccess) { grid = -1; return; }
        if (hipFuncSetAttribute((const void*)mk_fwd, hipFuncAttributeMaxDynamicSharedMemorySize, LDS_BYTES) != hipSuccess) { fprintf(stderr, "kernel_launch: hipFuncSetAttribute failed\n"); grid = -1; return; }
        if (hipOccupancyMaxActiveBlocksPerMultiprocessor(&per_cu, (const void*)mk_fwd, NWAVES * 64, LDS_BYTES) != hipSuccess || per_cu < 1) { fprintf(stderr, "kernel_launch: occupancy query says %d blocks per CU\n", per_cu); (void)hipGetLastError(); grid = -1; return; }
        grid = cus * per_cu;
    }
    if (grid < 0) return;
    Args a{};
    for (int i = 0; i < 12; ++i) a.in[i] = (const float*)d_in[i];
    a.out = (float*)d_out; a.ws = (unsigned char*)d_ws;
#if MK_N_LAUNCHES == 1
    a.ph_lo = 0; a.ph_hi = NPHASE;
    void* kargs[] = {&a};
    hipError_t e = hipLaunchCooperativeKernel((const void*)mk_fwd, dim3(grid), dim3(NWAVES * 64), kargs, LDS_BYTES, stream);
    if (e != hipSuccess) fprintf(stderr, "kernel_launch: cooperative launch failed: %s (grid %d)\n", hipGetErrorString(e), grid);
#else
    for (int p = 0; p < NPHASE; ++p) { a.ph_lo = p; a.ph_hi = p + 1; hipLaunchKernelGGL(mk_fwd, dim3(grid), dim3(NWAVES * 64), LDS_BYTES, stream, a); }
#endif
}
```

```cpp
#include <hip/hip_runtime.h>
#include <hip/hip_cooperative_groups.h>
#include <cstdio>
#include <cstdint>
namespace cg = cooperative_groups;
namespace pg8 {
#define PG8_LAS __attribute__((address_space(3)))
typedef unsigned short bf16_t;
typedef short bf16x8 __attribute__((ext_vector_type(8)));
typedef float f32x4 __attribute__((ext_vector_type(4)));
typedef unsigned u32x4 __attribute__((ext_vector_type(4)));
constexpr int BM = 256, BK = 64, HALF = 128, HTB = HALF * BK * 2  , STAGE_BYTES = 8 * HTB, NXCD = 8, WGM = 8;

__host__ __device__ __forceinline__ int lds_byte(int r, int c) { const int st = (r >> 4) * 2 + (c >> 5), rr = r & 15, cc = c & 31, ob = rr * 64 + cc * 2; return st * 1024 + (ob ^ (((ob >> 9) & 1) << 5)); }
__host__ __device__ __forceinline__ void stage_rc(int b, int& R, int& C) { const int st = b / 1024, sb = b % 1024, swz = sb ^ (((sb >> 9) & 1) << 5); R = (st >> 1) * 16 + swz / 64; C = (st & 1) * 32 + (swz % 64) / 2; }
__host__ __device__ __forceinline__ int perm32(int rho) { const int n = rho >> 4, i = rho & 15; return 8 * (i >> 2) + 4 * n + (i & 3); }

struct Unit { int pm, pn; };
struct Gemm { const bf16_t* A; const bf16_t* Bt; int M, N, K; };

struct StaticOrder {
    int nM, nN, nwg, G, c;
    __host__ __device__ void init(int M, int N, int G_, int c_) { nM = M / BM; nN = N / BM; nwg = nM * nN; G = G_; c = c_; }
    __host__ __device__ bool next(int i, Unit& u) const {
        const long L = (long)i * G + c; if (L >= nwg) return false;
        int wgid = (int)L; { const int q = nwg / NXCD, r = nwg % NXCD, xcd = wgid % NXCD, off = wgid / NXCD; wgid = (xcd < r ? xcd * (q + 1) : r * (q + 1) + (xcd - r) * q) + off; }
        const int nig = WGM * nN, gid = wgid / nig, fm = gid * WGM, gsz = (nM - fm) < WGM ? (nM - fm) : WGM;
        u.pm = fm + ((wgid % nig) % gsz); u.pn = (wgid % nig) / gsz; return true;
    }
    __device__ __forceinline__ void a_ready(const Unit&) const {}
    __device__ __forceinline__ void done(const Unit&) const {}
};

__device__ __forceinline__ unsigned cvt_pk_bf16(float lo, float hi) { unsigned r; asm volatile("v_cvt_pk_bf16_f32 %0, %1, %2" : "=v"(r) : "v"(lo), "v"(hi)); return r; }
typedef float f32x2 __attribute__((ext_vector_type(2)));
__device__ __forceinline__ f32x2 gelu_pk(f32x2 v) {
    const f32x2 av = __builtin_elementwise_abs(v), d = av * 0.2316418882f + 1.0f;
    f32x2 t; t.x = __builtin_amdgcn_rcpf(d.x); t.y = __builtin_amdgcn_rcpf(d.y);
    f32x2 q = t * 0.5307027145f + (-0.7265760135f); q = q * t + 0.7107068705f; q = q * t + (-0.142248368f); q = q * t + 0.127414796f; q = q * t;
    const f32x2 s = (v * v) * (-0.72134752044f);
    f32x2 e; e.x = __builtin_amdgcn_exp2f(s.x); e.y = __builtin_amdgcn_exp2f(s.y);
    const f32x2 m = v * (q * e), r = v - m;
    f32x2 o; o.x = v.x < 0.f ? m.x : r.x; o.y = v.y < 0.f ? m.y : r.y; return o;
}

template <int ACT  > struct EpiBf16 {
    static constexpr bool PERM = true, AFTER_DRAIN = false; static_assert(ACT == 0 || ACT == 1, "EpiBf16: ACT is 0 (none) or 1 (gelu_pk)");
    bf16_t* O; int ldc; const float* bias; int split_cols; size_t split_stride; float scale0;
    __device__ __forceinline__ void operator()(const f32x4 (&acc)[2][2][4][2], const Unit& u, int wr, int wc, int fr, int fq) const {
        const int row0 = u.pm * BM + wr * 64 + fr; int colt = u.pn * BM; bf16_t* base = O;
        float sc = 1.f; if (split_cols) { const int t = colt / split_cols; base += (size_t)t * split_stride; colt -= t * split_cols; if (t == 0) sc = scale0; }
        const int col0 = colt + wc * 32 + 8 * fq, bcol0 = u.pn * BM + wc * 32 + 8 * fq;
        f32x4 bv[2][2];
#pragma unroll
        for (int bj = 0; bj < 2; ++bj)
#pragma unroll
            for (int n = 0; n < 2; ++n) bv[bj][n] = bias ? *(const f32x4*)(bias + bcol0 + bj * HALF + 4 * n) : (f32x4){0.f, 0.f, 0.f, 0.f};
#pragma unroll
        for (int ai = 0; ai < 2; ++ai)
#pragma unroll
            for (int m = 0; m < 4; ++m) { bf16_t* rowp = base + (size_t)(row0 + ai * HALF + m * 16) * ldc + col0;
#pragma unroll
                for (int bj = 0; bj < 2; ++bj) { f32x4 v0 = acc[ai][bj][m][0] + bv[bj][0], v1 = acc[ai][bj][m][1] + bv[bj][1];
                    if (ACT == 1) { f32x2 a = gelu_pk((f32x2){v0[0], v0[1]}), b = gelu_pk((f32x2){v0[2], v0[3]}), c = gelu_pk((f32x2){v1[0], v1[1]}), d = gelu_pk((f32x2){v1[2], v1[3]});
                        v0 = (f32x4){a.x, a.y, b.x, b.y}; v1 = (f32x4){c.x, c.y, d.x, d.y}; }
                    v0 = v0 * sc; v1 = v1 * sc; u32x4 w; w.x = cvt_pk_bf16(v0[0], v0[1]); w.y = cvt_pk_bf16(v0[2], v0[3]); w.z = cvt_pk_bf16(v1[0], v1[1]); w.w = cvt_pk_bf16(v1[2], v1[3]);
                    *(u32x4*)(rowp + bj * HALF) = w; } }
    }
};
struct EpiY {
    static constexpr bool PERM = true, AFTER_DRAIN = false;
    bf16_t* Y; int ldc; float* ssq;
    __device__ __forceinline__ void operator()(const f32x4 (&acc)[2][2][4][2], const Unit& u, int wr, int wc, int fr, int fq) const {
        const int row0 = u.pm * BM + wr * 64 + fr; const int col0 = u.pn * BM + wc * 32 + 8 * fq;
#pragma unroll
        for (int ai = 0; ai < 2; ++ai)
#pragma unroll
            for (int m = 0; m < 4; ++m) { const int row = row0 + ai * HALF + m * 16; bf16_t* rowp = Y + (size_t)row * ldc + col0; float ss = 0.f;
#pragma unroll
                for (int bj = 0; bj < 2; ++bj) { const f32x4 v0 = acc[ai][bj][m][0], v1 = acc[ai][bj][m][1];
                    ss += (v0[0] * v0[0] + v0[1] * v0[1]) + (v0[2] * v0[2] + v0[3] * v0[3]) + (v1[0] * v1[0] + v1[1] * v1[1]) + (v1[2] * v1[2] + v1[3] * v1[3]);
                    u32x4 w; w.x = cvt_pk_bf16(v0[0], v0[1]); w.y = cvt_pk_bf16(v0[2], v0[3]); w.z = cvt_pk_bf16(v1[0], v1[1]); w.w = cvt_pk_bf16(v1[2], v1[3]);
                    *(u32x4*)(rowp + bj * HALF) = w; }
                ss += __shfl_xor(ss, 16); ss += __shfl_xor(ss, 32);
                if (fq == 0) ssq[(size_t)row * 32 + u.pn * 4 + wc] = ss; }
    }
};
struct EpiProj {
    static constexpr bool PERM = true, AFTER_DRAIN = false;
    bf16_t* P; bf16_t* QKV;
    __device__ __forceinline__ void operator()(const f32x4 (&acc)[2][2][4][2], const Unit& u, int wr, int wc, int fr, int fq) const {
        const int row0 = u.pm * BM + wr * 64 + fr, colt = u.pn * BM;
        if (colt < 4096 || colt >= 7168) {
            const int col0 = colt + wc * 32 + 8 * fq;
#pragma unroll
            for (int ai = 0; ai < 2; ++ai)
#pragma unroll
                for (int m = 0; m < 4; ++m) { bf16_t* rowp = P + (size_t)(row0 + ai * HALF + m * 16) * 8192 + col0;
#pragma unroll
                    for (int bj = 0; bj < 2; ++bj) { const f32x4 v0 = acc[ai][bj][m][0], v1 = acc[ai][bj][m][1];
                        u32x4 w; w.x = cvt_pk_bf16(v0[0], v0[1]); w.y = cvt_pk_bf16(v0[2], v0[3]); w.z = cvt_pk_bf16(v1[0], v1[1]); w.w = cvt_pk_bf16(v1[2], v1[3]);
                        *(u32x4*)(rowp + bj * HALF) = w; } }
        } else {
            const int which = (colt - 4096) >> 10, cin = ((colt - 4096) & 1023) + wc * 32 + 8 * fq;
            bf16_t* base = QKV + (size_t)which * (16384u * 1024u);
#pragma unroll
            for (int ai = 0; ai < 2; ++ai)
#pragma unroll
                for (int m = 0; m < 4; ++m) { const int row = row0 + ai * HALF + m * 16, b = row >> 11, t = row & 2047;
#pragma unroll
                    for (int bj = 0; bj < 2; ++bj) { const int c = cin + bj * HALF, head = c >> 6, d = c & 63;
                        const f32x4 v0 = acc[ai][bj][m][0], v1 = acc[ai][bj][m][1];
                        u32x4 w; w.x = cvt_pk_bf16(v0[0], v0[1]); w.y = cvt_pk_bf16(v0[2], v0[3]); w.z = cvt_pk_bf16(v1[0], v1[1]); w.w = cvt_pk_bf16(v1[2], v1[3]);
                        *(u32x4*)(base + ((size_t)((b * 16 + head) * 2048 + t)) * 64 + d) = w; } }
        }
    }
};
template <class Epi, class Sched, bool ALIGN_EPI = false, bool SP2 = false>
__device__ __forceinline__ void gemm_phase(PG8_LAS unsigned char* lds, const Gemm g, const Sched& S, const Epi& E) {
    const int tid = threadIdx.x, wid = __builtin_amdgcn_readfirstlane(tid >> 6), lane = tid & 63, wr = wid >> 2, wc = wid & 3, fr = lane & 15, fq = lane >> 4;
    const int K = g.K, nt = K / BK;
    unsigned voffA[2], voffB[2];
#pragma unroll
    for (int i = 0; i < 2; ++i) { int R, C; stage_rc(tid * 16 + i * 8192, R, C); const int Rb = Epi::PERM ? ((R & ~31) + perm32(R & 31)) : R;
        voffA[i] = (unsigned)(R * K + C) * 2u; voffB[i] = (unsigned)(Rb * K + C) * 2u; }
    const size_t kstep = (size_t)(BK * 2);
    const size_t hstep = (size_t)HALF * K * 2;
    const size_t tstep = 2 * hstep;
    const unsigned ldsw = (unsigned)wid * 1024u;
    const int aoff = lds_byte(wr * 64 + fr, fq * 8), boff = lds_byte(wc * 32 + fr, fq * 8);
#define PG8_SA(b, h) (((b) * 2 + (h)) * HTB)
#define PG8_SB(b, h) ((4 + (b) * 2 + (h)) * HTB)
#define PG8_STAGE(bufoff, gbase, voff) do { _Pragma("unroll") for (int _i = 0; _i < 2; ++_i) \
        __builtin_amdgcn_global_load_lds((const unsigned*)((const char*)(gbase) + (voff)[_i]), (PG8_LAS unsigned*)(lds + (bufoff) + ldsw + _i * 8192), 16, 0, 0); } while (0)
#define PG8_LDA(dst, b, h) do { _Pragma("unroll") for (int m = 0; m < 4; ++m) _Pragma("unroll") for (int k = 0; k < 2; ++k) dst[m][k] = *(const PG8_LAS bf16x8*)(lds + PG8_SA(b, h) + aoff + m * 2048 + k * 1024); } while (0)
#define PG8_LDB(dst, b, h) do { _Pragma("unroll") for (int n = 0; n < 2; ++n) _Pragma("unroll") for (int k = 0; k < 2; ++k) dst[n][k] = *(const PG8_LAS bf16x8*)(lds + PG8_SB(b, h) + boff + n * 2048 + k * 1024); } while (0)
#define PG8_MMA(ai, bj, At, Bt) do { __builtin_amdgcn_s_setprio(1); _Pragma("unroll") for (int m = 0; m < 4; ++m) _Pragma("unroll") for (int n = 0; n < 2; ++n) _Pragma("unroll") for (int k = 0; k < 2; ++k) \
        acc[ai][bj][m][n] = __builtin_amdgcn_mfma_f32_16x16x32_bf16(Bt[n][k], At[m][k], acc[ai][bj][m][n], 0, 0, 0); __builtin_amdgcn_s_setprio(0); } while (0)
#define PG8_WAIT_V(n) asm volatile("s_waitcnt vmcnt(" #n ")" ::: "memory")
#define PG8_WAIT_L(n) asm volatile("s_waitcnt lgkmcnt(" #n ")" ::: "memory")
#define PG8_BAR __builtin_amdgcn_s_barrier()
#define PG8_SCHED __builtin_amdgcn_sched_barrier(0)
    Unit cur, nxt; int ui = 0;
    if (!S.next(0, cur)) return;
    f32x4 acc[2][2][4][2];
#pragma unroll
    for (int a = 0; a < 2; ++a)
#pragma unroll
        for (int b = 0; b < 2; ++b)
#pragma unroll
            for (int m = 0; m < 4; ++m)
#pragma unroll
                for (int n = 0; n < 2; ++n) acc[a][b][m][n] = (f32x4){0.f, 0.f, 0.f, 0.f};
    bf16x8 At[4][2], B0[2][2], B1[2][2];
    const char* cA = (const char*)g.A + (size_t)cur.pm * tstep; const char* cB = (const char*)g.Bt + (size_t)cur.pn * tstep;
    S.a_ready(cur);
    if constexpr (SP2) {
        PG8_STAGE(PG8_SB(0, 0), cB, voffB); PG8_STAGE(PG8_SB(0, 1), cB + hstep, voffB); PG8_STAGE(PG8_SA(0, 0), cA, voffA); PG8_STAGE(PG8_SA(0, 1), cA + hstep, voffA);
        if (wr == 1) PG8_BAR;
        PG8_WAIT_V(2); PG8_BAR;
        PG8_STAGE(PG8_SB(1, 0), cB + kstep, voffB); PG8_STAGE(PG8_SA(1, 0), cA + kstep, voffA); PG8_STAGE(PG8_SB(1, 1), cB + hstep + kstep, voffB);
        PG8_WAIT_V(6); PG8_BAR;
    } else {
        PG8_STAGE(PG8_SB(0, 0), cB, voffB); PG8_STAGE(PG8_SA(0, 0), cA, voffA); PG8_STAGE(PG8_SB(0, 1), cB + hstep, voffB); PG8_STAGE(PG8_SA(0, 1), cA + hstep, voffA);
        if (wr == 1) PG8_BAR;
        PG8_WAIT_V(4); PG8_BAR;
        PG8_STAGE(PG8_SB(1, 0), cB + kstep, voffB); PG8_STAGE(PG8_SA(1, 0), cA + kstep, voffA); PG8_STAGE(PG8_SB(1, 1), cB + hstep + kstep, voffB);
        PG8_WAIT_V(6); PG8_BAR;
    }
    for (;;) {
        const bool has_next = S.next(ui + 1, nxt);
        const char* nA = has_next ? (const char*)g.A + (size_t)nxt.pm * tstep : cA; const char* nB = has_next ? (const char*)g.Bt + (size_t)nxt.pn * tstep : cB;
        for (int t = 0; t < nt; t += 2) {
            const bool last = (t == nt - 2);
            const char* a1 = cA + (size_t)(t + 1) * kstep;
            const char* a2 = last ? nA : cA + (size_t)(t + 2) * kstep; const char* b2 = last ? nB : cB + (size_t)(t + 2) * kstep;
            const char* a3 = a2 + kstep; const char* b3 = b2 + kstep;
            if (last && has_next) S.a_ready(nxt);
            if constexpr (SP2) {
            PG8_LDB(B0, 0, 0); PG8_LDB(B1, 0, 1); PG8_SCHED; PG8_LDA(At, 0, 0); PG8_STAGE(PG8_SA(1, 1), a1 + hstep, voffA);
            PG8_WAIT_V(8); PG8_WAIT_L(0); PG8_BAR; PG8_MMA(0, 0, At, B0); PG8_MMA(0, 1, At, B1); PG8_BAR; PG8_SCHED;
            PG8_LDA(At, 0, 1); PG8_STAGE(PG8_SB(0, 0), b2, voffB); PG8_STAGE(PG8_SB(0, 1), b2 + hstep, voffB); PG8_STAGE(PG8_SA(0, 0), a2, voffA);
            PG8_WAIT_V(8); PG8_WAIT_L(0); PG8_BAR; PG8_MMA(1, 0, At, B0); PG8_MMA(1, 1, At, B1); PG8_BAR; PG8_SCHED;
            PG8_LDB(B0, 1, 0); PG8_LDB(B1, 1, 1); PG8_SCHED; PG8_LDA(At, 1, 0); PG8_STAGE(PG8_SA(0, 1), a2 + hstep, voffA);
            PG8_WAIT_V(8); PG8_WAIT_L(0); PG8_BAR; PG8_MMA(0, 0, At, B0); PG8_MMA(0, 1, At, B1); PG8_BAR; PG8_SCHED;
            PG8_LDA(At, 1, 1); PG8_STAGE(PG8_SB(1, 0), b3, voffB); PG8_STAGE(PG8_SB(1, 1), b3 + hstep, voffB); PG8_STAGE(PG8_SA(1, 0), a3, voffA);
            PG8_WAIT_V(8); PG8_WAIT_L(0); PG8_BAR; PG8_MMA(1, 0, At, B0); PG8_MMA(1, 1, At, B1); PG8_BAR; PG8_SCHED;
            } else {
            PG8_LDB(B0, 0, 0); PG8_SCHED; PG8_LDA(At, 0, 0); PG8_STAGE(PG8_SA(1, 1), a1 + hstep, voffA);
            PG8_WAIT_L(8); PG8_BAR; PG8_WAIT_L(0); PG8_MMA(0, 0, At, B0); PG8_BAR; PG8_SCHED;
            PG8_LDB(B1, 0, 1); PG8_STAGE(PG8_SB(0, 0), b2, voffB);
            PG8_BAR; PG8_WAIT_L(0); PG8_MMA(0, 1, At, B1); PG8_BAR;
            PG8_LDA(At, 0, 1); PG8_STAGE(PG8_SA(0, 0), a2, voffA);
            PG8_BAR; PG8_WAIT_L(0); PG8_MMA(1, 0, At, B0); PG8_BAR; PG8_SCHED;
            PG8_STAGE(PG8_SB(0, 1), b2 + hstep, voffB);
            PG8_WAIT_V(6); PG8_BAR; PG8_MMA(1, 1, At, B1); PG8_BAR;
            PG8_LDB(B0, 1, 0); PG8_SCHED; PG8_LDA(At, 1, 0); PG8_STAGE(PG8_SA(0, 1), a2 + hstep, voffA);
            PG8_WAIT_L(8); PG8_BAR; PG8_WAIT_L(0); PG8_MMA(0, 0, At, B0); PG8_BAR; PG8_SCHED;
            PG8_LDB(B1, 1, 1); PG8_STAGE(PG8_SB(1, 0), b3, voffB);
            PG8_BAR; PG8_WAIT_L(0); PG8_MMA(0, 1, At, B1); PG8_BAR;
            PG8_LDA(At, 1, 1); PG8_STAGE(PG8_SA(1, 0), a3, voffA);
            PG8_BAR; PG8_WAIT_L(0); PG8_MMA(1, 0, At, B0); PG8_BAR; PG8_SCHED;
            PG8_STAGE(PG8_SB(1, 1), b3 + hstep, voffB);
            PG8_WAIT_V(6); PG8_BAR; PG8_MMA(1, 1, At, B1); PG8_BAR;
            }
        }
        if constexpr (ALIGN_EPI) { if (wr == 0) PG8_BAR; }
        if constexpr (!Epi::AFTER_DRAIN) { E(acc, cur, wr, wc, fr, fq); S.done(cur); }
        if (!has_next) break;
#pragma unroll
        for (int a = 0; a < 2; ++a)
#pragma unroll
            for (int b = 0; b < 2; ++b)
#pragma unroll
                for (int m = 0; m < 4; ++m)
#pragma unroll
                    for (int n = 0; n < 2; ++n) acc[a][b][m][n] = (f32x4){0.f, 0.f, 0.f, 0.f};
        cur = nxt; cA = nA; cB = nB; ++ui;
        if constexpr (ALIGN_EPI) { if (wr == 1) PG8_BAR; }
    }
    PG8_WAIT_V(0);
    if constexpr (!ALIGN_EPI) { if (wr == 0) PG8_BAR; }
    PG8_BAR;
    if constexpr (Epi::AFTER_DRAIN) { E.fused(acc, cur, wr, wc, fr, fq, lds, wid, lane); S.done(cur); }
#undef PG8_SA
#undef PG8_SB
#undef PG8_STAGE
#undef PG8_LDA
#undef PG8_LDB
#undef PG8_MMA
#undef PG8_WAIT_V
#undef PG8_WAIT_L
#undef PG8_BAR
#undef PG8_SCHED
}
}

#ifndef PG8_SP2
#define PG8_SP2 true
#endif
#ifndef PG8_ALIGN
#define PG8_ALIGN true
#endif
#ifndef MK_N_LAUNCHES
#define MK_N_LAUNCHES 1
#endif
#ifndef ATTN_NAIVE
#define ATTN_NAIVE 0
#endif

using pg8::bf16_t; using pg8::bf16x8; using pg8::f32x4; using pg8::u32x4;
typedef unsigned u32x2 __attribute__((ext_vector_type(2)));
typedef float f32x2 __attribute__((ext_vector_type(2)));
#define LAS __attribute__((address_space(3)))
constexpr int BATCH = 8, SEQ = 2048, DM = 2048, MTOK = BATCH * SEQ, NPROJ = 8192, DG = 1024, NH = 16, HD = 64, NMOD = 3 * DM;
constexpr int OFF_U = 0, OFF_B = 1024, OFF_C = 2048, OFF_ZC = 3072, OFF_Q = 4096, OFF_K = 5120, OFF_V = 6144, OFF_ZA = 7168;
constexpr float EPS = 1e-6f, LOG2E = 1.4426950408889634f;
constexpr int KSPLIT = 16, NWAVES = 8, NPHASE = 7;
constexpr size_t MiB = 1u << 20;
constexpr size_t WS_MODP = 1 * MiB, WS_GATE = 4 * MiB, WS_SSQA = 5 * MiB, WS_SSQY = 6 * MiB, WS_WOUTT = 8 * MiB, WS_WINT = 16 * MiB, WS_O = 48 * MiB,
                 WS_H = 80 * MiB, WS_YCAT = WS_H  , WS_PROJ = 144 * MiB, WS_Y = WS_PROJ  , WS_QKV = 400 * MiB  , WS_END = 496 * MiB;
constexpr int LDS_BYTES = 147456;

#define LDS_WAIT() asm volatile("s_waitcnt lgkmcnt(0)" ::: "memory")
__device__ __forceinline__ float bf_lo(unsigned u) { return __uint_as_float(u << 16); }
__device__ __forceinline__ float bf_hi(unsigned u) { return __uint_as_float(u & 0xffff0000u); }
__device__ __forceinline__ unsigned pk(float lo, float hi) { return pg8::cvt_pk_bf16(lo, hi); }
__device__ __forceinline__ float silu_f(float v) { return v * __builtin_amdgcn_rcpf(1.f + __builtin_amdgcn_exp2f(-v * LOG2E)); }
__device__ __forceinline__ float wave_sum(float v) {
#pragma unroll
    for (int o = 1; o < 64; o <<= 1) v += __shfl_xor(v, o);
    return v;
}
__device__ __forceinline__ void unpack8(const u32x4 w, float* f) { f[0] = bf_lo(w.x); f[1] = bf_hi(w.x); f[2] = bf_lo(w.y); f[3] = bf_hi(w.y); f[4] = bf_lo(w.z); f[5] = bf_hi(w.z); f[6] = bf_lo(w.w); f[7] = bf_hi(w.w); }
__device__ __forceinline__ void load16(const bf16_t* rowp, int lane, float (&f)[16]) {
    const u32x4 a = *(const u32x4*)(rowp + 8 * lane), b = *(const u32x4*)(rowp + 512 + 8 * lane); unpack8(a, f); unpack8(b, f + 8);
}
__device__ __forceinline__ void load16f(const float* p, int lane, float (&f)[16]) {
#pragma unroll
    for (int j = 0; j < 2; ++j) { const f32x4 a = *(const f32x4*)(p + 512 * j + 8 * lane), b = *(const f32x4*)(p + 512 * j + 8 * lane + 4);
        f[8 * j + 0] = a[0]; f[8 * j + 1] = a[1]; f[8 * j + 2] = a[2]; f[8 * j + 3] = a[3]; f[8 * j + 4] = b[0]; f[8 * j + 5] = b[1]; f[8 * j + 6] = b[2]; f[8 * j + 7] = b[3]; }
}
__device__ __forceinline__ void store16(bf16_t* rowp, int lane, const float (&y)[16]) {
#pragma unroll
    for (int j = 0; j < 2; ++j) { u32x4 w; w.x = pk(y[8 * j + 0], y[8 * j + 1]); w.y = pk(y[8 * j + 2], y[8 * j + 3]); w.z = pk(y[8 * j + 4], y[8 * j + 5]); w.w = pk(y[8 * j + 6], y[8 * j + 7]);
        *(u32x4*)(rowp + 512 * j + 8 * lane) = w; }
}

__device__ __forceinline__ void p0_transpose_item(const float* __restrict__ W, int K, int N, bf16_t* __restrict__ WT, LAS float* scr, int item, int lane) {
    const int nblk = N / 32, kb = item / nblk, nb = item % nblk, k0 = 64 * kb, n0 = 32 * nb;
#pragma unroll 8
    for (int i = 0; i < 32; ++i) { const int kk = 2 * i + (lane >> 5); scr[kk * 33 + (lane & 31)] = W[(size_t)(k0 + kk) * N + n0 + (lane & 31)]; }
    LDS_WAIT();
    const int c = lane & 7;
#pragma unroll
    for (int j = 0; j < 4; ++j) { const int n = (lane >> 3) + 8 * j; const LAS float* s = scr + (8 * c) * 33 + n;
        u32x4 o; o.x = pk(s[0 * 33], s[1 * 33]); o.y = pk(s[2 * 33], s[3 * 33]); o.z = pk(s[4 * 33], s[5 * 33]); o.w = pk(s[6 * 33], s[7 * 33]);
        *(u32x4*)(WT + (size_t)(n0 + n) * K + k0 + 8 * c) = o; }
    LDS_WAIT();
}
__device__ __forceinline__ void p0_mod_item(const float* __restrict__ cvec, const float* __restrict__ wada, float* __restrict__ modp, LAS float* scr, int item, int lane) {
    const int kc = item / 48, nc = item % 48, k0 = kc * 128, n0 = nc * 128;
#pragma unroll
    for (int i = 0; i < 16; ++i) { const int idx = i * 64 + lane, b = idx >> 7, kk = idx & 127; scr[kk * 8 + b] = silu_f(cvec[b * DM + k0 + kk]); }
    LDS_WAIT();
    float acc[8][2];
#pragma unroll
    for (int b = 0; b < 8; ++b) { acc[b][0] = 0.f; acc[b][1] = 0.f; }
    const float* wp = wada + (size_t)k0 * NMOD + n0 + 2 * lane;
#pragma unroll 8
    for (int kk = 0; kk < 128; ++kk) {
        const f32x2 w = *(const f32x2*)(wp + (size_t)kk * NMOD);
        const f32x4 s0 = *(const LAS f32x4*)(scr + kk * 8), s1 = *(const LAS f32x4*)(scr + kk * 8 + 4);
        acc[0][0] += s0[0] * w[0]; acc[0][1] += s0[0] * w[1]; acc[1][0] += s0[1] * w[0]; acc[1][1] += s0[1] * w[1];
        acc[2][0] += s0[2] * w[0]; acc[2][1] += s0[2] * w[1]; acc[3][0] += s0[3] * w[0]; acc[3][1] += s0[3] * w[1];
        acc[4][0] += s1[0] * w[0]; acc[4][1] += s1[0] * w[1]; acc[5][0] += s1[1] * w[0]; acc[5][1] += s1[1] * w[1];
        acc[6][0] += s1[2] * w[0]; acc[6][1] += s1[2] * w[1]; acc[7][0] += s1[3] * w[0]; acc[7][1] += s1[3] * w[1];
    }
#pragma unroll
    for (int b = 0; b < 8; ++b) *(f32x2*)(modp + ((size_t)kc * 8 + b) * NMOD + n0 + 2 * lane) = (f32x2){acc[b][0], acc[b][1]};
    LDS_WAIT();
}

__device__ __forceinline__ void p1_rows(const float* __restrict__ x, const float* __restrict__ b_ada, const float* __restrict__ g_pre, const float* __restrict__ modp,
                                        float* __restrict__ gate, bf16_t* __restrict__ hbuf, LAS unsigned char* lds, int bx, int G, int tid, int wave, int lane) {
    LAS float* Ac = (LAS float*)lds; LAS float* Sc = Ac + DM;
    for (int chunk = bx; chunk < MTOK / 64; chunk += G) {
        const int b = chunk >> 5;
        __syncthreads();
        { const int d = tid * 4;
          f32x4 sh = *(const f32x4*)(b_ada + d), sc = *(const f32x4*)(b_ada + DM + d);
#pragma unroll 4
          for (int kc = 0; kc < KSPLIT; ++kc) { const float* p = modp + ((size_t)kc * 8 + b) * NMOD + d; sh += *(const f32x4*)p; sc += *(const f32x4*)(p + DM); }
          const f32x4 g = *(const f32x4*)(g_pre + d);
          *(LAS f32x4*)(Ac + d) = g * (sc + 1.0f); *(LAS f32x4*)(Sc + d) = sh;
          if ((chunk & 31) == 0) { f32x4 gt = *(const f32x4*)(b_ada + 2 * DM + d);
#pragma unroll 4
              for (int kc = 0; kc < KSPLIT; ++kc) gt += *(const f32x4*)(modp + ((size_t)kc * 8 + b) * NMOD + 2 * DM + d);
              *(f32x4*)(gate + b * DM + d) = gt; } }
        __syncthreads();
        for (int i = 0; i < 8; ++i) {
            const int row = chunk * 64 + wave * 8 + i;
            const f32x4* xr = (const f32x4*)(x + (size_t)row * DM) + lane;
            f32x4 v[8]; float s = 0.f;
#pragma unroll
            for (int j = 0; j < 8; ++j) { v[j] = xr[64 * j]; s += (v[j][0] * v[j][0] + v[j][1] * v[j][1]) + (v[j][2] * v[j][2] + v[j][3] * v[j][3]); }
            const float rstd = 1.0f / sqrtf(wave_sum(s) * (1.0f / DM) + EPS);
            u32x2* o8 = (u32x2*)(hbuf + (size_t)row * DM) + lane;
#pragma unroll
            for (int j = 0; j < 8; ++j) { const int d = 4 * lane + 256 * j; const f32x4 a = *(const LAS f32x4*)(Ac + d), sft = *(const LAS f32x4*)(Sc + d);
                const f32x4 o = v[j] * rstd * a + sft; u32x2 w; w.x = pk(o[0], o[1]); w.y = pk(o[2], o[3]); o8[64 * j] = w; }
        }
    }
}

__device__ __forceinline__ void conv_unit(const bf16_t* __restrict__ proj, const float* __restrict__ cw, const float* __restrict__ cb, const float* __restrict__ gc,
                                          bf16_t* __restrict__ ycat, int unit, int wave, int lane) {
    const int tk0 = unit * 64 + wave * 8, t0 = tk0 & (SEQ - 1);
    float w0[16], w1[16], w2[16], bb[16];
    load16f(cw, lane, w0); load16f(cw + DG, lane, w1); load16f(cw + 2 * DG, lane, w2); load16f(cb, lane, bb);
    float pp[16], pc[16], pn[16], ta[16], tb[16];
    const bf16_t* base = proj + (size_t)tk0 * NPROJ;
    if (t0 > 0) { load16(base - NPROJ + OFF_C, lane, ta); load16(base - NPROJ + OFF_U, lane, tb);
#pragma unroll
        for (int e = 0; e < 16; ++e) pp[e] = ta[e] * tb[e]; }
    else {
#pragma unroll
        for (int e = 0; e < 16; ++e) pp[e] = 0.f; }
    load16(base + OFF_C, lane, ta); load16(base + OFF_U, lane, tb);
#pragma unroll
    for (int e = 0; e < 16; ++e) pc[e] = ta[e] * tb[e];
#pragma unroll 1
    for (int i = 0; i < 8; ++i) {
        const bf16_t* rp = base + (size_t)i * NPROJ;
        if (t0 + i + 1 < SEQ) { load16(rp + NPROJ + OFF_C, lane, ta); load16(rp + NPROJ + OFF_U, lane, tb);
#pragma unroll
            for (int e = 0; e < 16; ++e) pn[e] = ta[e] * tb[e]; }
        else {
#pragma unroll
            for (int e = 0; e < 16; ++e) pn[e] = 0.f; }
        load16(rp + OFF_B, lane, ta); load16(rp + OFF_ZC, lane, tb);
        float v[16], ss = 0.f;
#pragma unroll
        for (int e = 0; e < 16; ++e) { v[e] = ta[e] * (w0[e] * pp[e] + w1[e] * pc[e] + w2[e] * pn[e] + bb[e]); ss += v[e] * v[e]; }
        const float rstd = 1.0f / sqrtf(wave_sum(ss) * (1.0f / DG) + EPS);
        float g[16]; load16f(gc, lane, g);
#pragma unroll
        for (int e = 0; e < 16; ++e) v[e] = v[e] * rstd * g[e] * silu_f(tb[e]);
        store16(ycat + (size_t)(tk0 + i) * DM, lane, v);
#pragma unroll
        for (int e = 0; e < 16; ++e) { pp[e] = pc[e]; pc[e] = pn[e]; }
    }
}

#if ATTN_NAIVE
__device__ __forceinline__ void attn_naive_item(const bf16_t* __restrict__ qkv, bf16_t* __restrict__ obuf, float* __restrict__ ssqa, int item, int tid) {
    const int bh = item >> 2, b = bh >> 4, h = bh & 15, t = (item & 3) * 512 + tid;
    const size_t tokb = (size_t)b * SEQ;
    float q[64], O[64];
    const bf16_t* qh = qkv + (size_t)bh * SEQ * HD; const bf16_t* kh = qh + (size_t)MTOK * DG; const bf16_t* vh = kh + (size_t)MTOK * DG;
    { const u32x4* qp = (const u32x4*)(qh + (size_t)t * HD);
#pragma unroll
      for (int i = 0; i < 8; ++i) { const u32x4 w = qp[i]; unpack8(w, q + 8 * i); } }
#pragma unroll
    for (int d = 0; d < 64; ++d) O[d] = 0.f;
    float M = -1e30f, Ls = 0.f;
    const float slope = exp2f(-0.5f * (float)(h + 1));
    for (int br = 0; br < 3; ++br) {
        const int R = br == 0 ? 1 : (br == 1 ? 4 : 16); const float sr = slope * (float)R;
        for (int j = -64; j <= 64; ++j) {
            const int pos = t + R * j; if (pos < 0 || pos >= SEQ) continue;
            const u32x4* kp = (const u32x4*)(kh + (size_t)pos * HD); const u32x4* vp = (const u32x4*)(vh + (size_t)pos * HD);
            float dot = 0.f;
#pragma unroll
            for (int i = 0; i < 8; ++i) { const u32x4 w = kp[i]; float kf[8]; unpack8(w, kf);
#pragma unroll
                for (int e = 0; e < 8; ++e) dot += q[8 * i + e] * kf[e]; }
            const float s = dot * 0.125f - sr * fabsf((float)j);
            const float mn = fmaxf(M, s), a = __expf(M - mn), p = __expf(s - mn); Ls = Ls * a + p; M = mn;
#pragma unroll
            for (int i = 0; i < 8; ++i) { const u32x4 w = vp[i]; float vf[8]; unpack8(w, vf);
#pragma unroll
                for (int e = 0; e < 8; ++e) O[8 * i + e] = O[8 * i + e] * a + p * vf[e]; }
        }
    }
    const float inv = 1.0f / Ls; float ss = 0.f;
    u32x4* op = (u32x4*)(obuf + (tokb + t) * DG + h * HD);
#pragma unroll
    for (int i = 0; i < 8; ++i) { float o[8];
#pragma unroll
        for (int e = 0; e < 8; ++e) { o[e] = O[8 * i + e] * inv; ss += o[e] * o[e]; }
        u32x4 w; w.x = pk(o[0], o[1]); w.y = pk(o[2], o[3]); w.z = pk(o[4], o[5]); w.w = pk(o[6], o[7]); op[i] = w; }
    ssqa[(tokb + t) * NH + h] = ss;
}
constexpr int NATT = BATCH * NH * 4;
#else
namespace att {
constexpr int OST = 68;
constexpr int LDS_O = 0, LDS_ML = 256 * OST * 4, LDS_V = LDS_ML + 2048, VROW = 144, VWAVE = 32 * VROW;
static_assert(LDS_V + NWAVES * VWAVE <= LDS_BYTES, "attention LDS map");
typedef short v4i16_t __attribute__((ext_vector_type(4)));
__device__ __forceinline__ v4i16_t vtr(LAS unsigned char* p) { return __builtin_amdgcn_ds_read_tr16_b64_v4i16((LAS v4i16_t*)p); }
#define CFENCE() asm volatile("" ::: "memory")

template <int R, bool FIRST>
__device__ __forceinline__ void branch_unit(const bf16_t* __restrict__ qh, const bf16_t* __restrict__ kh, const bf16_t* __restrict__ vh, int P0, int Gi, float sl2  , LAS unsigned char* lds, int wave, int lane) {
    constexpr int L = SEQ / R;
    asm volatile("" : "+v"(lane));
    const int q = lane & 15, quad = lane >> 4;
    const int rho = Gi % R, gi = Gi / R, I0 = P0 / R + 16 * gi;
    const bf16_t* vb = vh + 8 * (lane & 7);
    const bf16_t* qp = qh + (size_t)(rho + R * (I0 + q)) * HD + 8 * quad;
    const bf16x8 qf0 = *(const bf16x8*)qp, qf1 = *(const bf16x8*)(qp + 32);
    f32x4 s[5][2];
    {
        bf16x8 kf[5][2][2];
#pragma unroll
        for (int tau = 0; tau < 5; ++tau)
#pragma unroll
            for (int hf = 0; hf < 2; ++hf) { int Ik = I0 - 64 + 32 * tau + 16 * hf + q; Ik = Ik < 0 ? 0 : (Ik > L - 1 ? L - 1 : Ik);
                const bf16_t* kp = kh + (size_t)(rho + R * Ik) * HD + 8 * quad; kf[tau][hf][0] = *(const bf16x8*)kp; kf[tau][hf][1] = *(const bf16x8*)(kp + 32); }
#pragma unroll
        for (int tau = 0; tau < 5; ++tau)
#pragma unroll
            for (int hf = 0; hf < 2; ++hf) { f32x4 acc = (f32x4){0.f, 0.f, 0.f, 0.f};
                acc = __builtin_amdgcn_mfma_f32_16x16x32_bf16(kf[tau][hf][0], qf0, acc, 0, 0, 0);
                acc = __builtin_amdgcn_mfma_f32_16x16x32_bf16(kf[tau][hf][1], qf1, acc, 0, 0, 0);
                s[tau][hf] = acc; }
    }
    u32x4 vv[5][4];
#pragma unroll
    for (int tau = 0; tau < 5; ++tau)
#pragma unroll
        for (int it = 0; it < 4; ++it) { int Ik = I0 - 64 + 32 * tau + (lane >> 3) + 8 * it; Ik = Ik < 0 ? 0 : (Ik > L - 1 ? L - 1 : Ik); vv[tau][it] = *(const u32x4*)(vb + (size_t)(rho + R * Ik) * HD); }
    const float relb = (float)(4 * quad - 64 - q); const int ikb = I0 - 64 + 4 * quad; const float c1 = 0.125f * LOG2E;
    float m = -1e30f;
#pragma unroll
    for (int tau = 0; tau < 5; ++tau)
#pragma unroll
        for (int hf = 0; hf < 2; ++hf)
#pragma unroll
            for (int i = 0; i < 4; ++i) { const int kc = 32 * tau + 16 * hf + i; const float rel = relb + (float)kc, arel = fabsf(rel); const int Ik = ikb + kc;
                const bool ok = (arel <= 64.f) && ((unsigned)Ik < (unsigned)L);
                float v = s[tau][hf][i] * c1 - sl2 * arel; v = ok ? v : -1e30f; s[tau][hf][i] = v; m = fmaxf(m, v); }
    m = fmaxf(m, __shfl_xor(m, 16)); m = fmaxf(m, __shfl_xor(m, 32));
    float lsum = 0.f; bf16x8 pb[5];
#pragma unroll
    for (int tau = 0; tau < 5; ++tau) { float p[8];
#pragma unroll
        for (int i = 0; i < 4; ++i) { p[i] = __builtin_amdgcn_exp2f(s[tau][0][i] - m); p[4 + i] = __builtin_amdgcn_exp2f(s[tau][1][i] - m); }
        lsum += ((p[0] + p[1]) + (p[2] + p[3])) + ((p[4] + p[5]) + (p[6] + p[7]));
        u32x4 w; w.x = pk(p[0], p[1]); w.y = pk(p[2], p[3]); w.z = pk(p[4], p[5]); w.w = pk(p[6], p[7]); pb[tau] = __builtin_bit_cast(bf16x8, w); }
    f32x4 o[4];
#pragma unroll
    for (int c = 0; c < 4; ++c) o[c] = (f32x4){0.f, 0.f, 0.f, 0.f};
    LAS unsigned char* vst = lds + LDS_V + wave * VWAVE;
    LAS unsigned char* vwr = vst + (lane >> 3) * VROW + (lane & 7) * 16;
    LAS unsigned char* vrd = vst + (4 * quad + (q >> 2)) * VROW + 8 * (q & 3);
#pragma unroll
    for (int tau = 0; tau < 5; ++tau) {
#pragma unroll
        for (int it = 0; it < 4; ++it) *(LAS u32x4*)(vwr + 8 * it * VROW) = vv[tau][it];
        LDS_WAIT();
#pragma unroll
        for (int c = 0; c < 4; ++c) { const v4i16_t lo = vtr(vrd + 32 * c), hi = vtr(vrd + 16 * VROW + 32 * c);
            const bf16x8 a = (bf16x8){lo[0], lo[1], lo[2], lo[3], hi[0], hi[1], hi[2], hi[3]};
            o[c] = __builtin_amdgcn_mfma_f32_16x16x32_bf16(a, pb[tau], o[c], 0, 0, 0); }
        LDS_WAIT();
    }
    float l = lsum + __shfl_xor(lsum, 16); l += __shfl_xor(l, 32);
    const int ql = rho + R * (16 * gi + q);
    LAS float* Or = (LAS float*)(lds + LDS_O) + ql * OST + 4 * quad;
    LAS float* ML = (LAS float*)(lds + LDS_ML) + 2 * ql;
    if (FIRST) {
#pragma unroll
        for (int c = 0; c < 4; ++c) *(LAS f32x4*)(Or + 16 * c) = o[c];
        if (quad == 0) { ML[0] = m; ML[1] = l; }
    } else {
        const float Mo = ML[0], Lo = ML[1]; const float mn = fmaxf(Mo, m), a = __builtin_amdgcn_exp2f(Mo - mn), bs = __builtin_amdgcn_exp2f(m - mn);
#pragma unroll
        for (int c = 0; c < 4; ++c) { const f32x4 t = *(LAS f32x4*)(Or + 16 * c); *(LAS f32x4*)(Or + 16 * c) = t * a + o[c] * bs; }
        LDS_WAIT();
        if (quad == 0) { ML[0] = mn; ML[1] = Lo * a + l * bs; }
    }
}

__device__ __forceinline__ void attn_final(bf16_t* __restrict__ obuf, float* __restrict__ ssqa, size_t tokb, int h, int P0, LAS unsigned char* lds, int wave, int lane) {
#pragma unroll
    for (int it = 0; it < 4; ++it) { const int row = 32 * wave + (lane >> 3) + 8 * it, ch = lane & 7;
        LAS float* Or = (LAS float*)(lds + LDS_O) + row * OST + 8 * ch; f32x4 a = *(LAS f32x4*)Or, b = *(LAS f32x4*)(Or + 4);
        const float inv = 1.0f / ((LAS float*)(lds + LDS_ML))[2 * row + 1];
        a = a * inv; b = b * inv;
        float ss = ((a[0] * a[0] + a[1] * a[1]) + (a[2] * a[2] + a[3] * a[3])) + ((b[0] * b[0] + b[1] * b[1]) + (b[2] * b[2] + b[3] * b[3]));
        u32x4 w; w.x = pk(a[0], a[1]); w.y = pk(a[2], a[3]); w.z = pk(b[0], b[1]); w.w = pk(b[2], b[3]);
        *(u32x4*)(obuf + (tokb + P0 + row) * DG + h * HD + 8 * ch) = w;
        ss += __shfl_xor(ss, 1); ss += __shfl_xor(ss, 2); ss += __shfl_xor(ss, 4);
        if (ch == 0) ssqa[(tokb + P0 + row) * NH + h] = ss; }
}
}
constexpr int NATT = BATCH * NH * 8;
__device__ __forceinline__ void attn_unit(const bf16_t* __restrict__ qkv, bf16_t* __restrict__ obuf, float* __restrict__ ssqa, LAS unsigned char* lds, int item, int wave, int lane) {
    const int bh = item >> 3, qb = item & 7, b = bh >> 4, h = bh & 15, P0 = qb * 256;
    const size_t tokb = (size_t)b * SEQ;
    const bf16_t* qh = qkv + (size_t)bh * SEQ * HD; const bf16_t* kh = qh + (size_t)MTOK * DG; const bf16_t* vh = kh + (size_t)MTOK * DG;
    const float sl2 = exp2f(-0.5f * (float)(h + 1)) * LOG2E;
#pragma unroll 1
    for (int g2 = 0; g2 < 2; ++g2) att::branch_unit<1, true>(qh, kh, vh, P0, wave + 8 * g2, sl2, lds, wave, lane);
    __syncthreads();
#pragma unroll 1
    for (int g2 = 0; g2 < 2; ++g2) att::branch_unit<4, false>(qh, kh, vh, P0, wave + 8 * g2, sl2 * 4.f, lds, wave, lane);
    __syncthreads();
#pragma unroll 1
    for (int g2 = 0; g2 < 2; ++g2) att::branch_unit<16, false>(qh, kh, vh, P0, wave + 8 * g2, sl2 * 16.f, lds, wave, lane);
    __syncthreads();
    att::attn_final(obuf, ssqa, tokb, h, P0, lds, wave, lane);
    __syncthreads();
}

#endif

struct Args { const float* in[12]; float* out; unsigned char* ws; int ph_lo, ph_hi; };
__global__ void __launch_bounds__(NWAVES * 64, 2) mk_fwd(Args args) {
    extern __shared__ __attribute__((aligned(16))) unsigned char lds_raw[];
    LAS unsigned char* lds = (LAS unsigned char*)lds_raw;
    const int tid = threadIdx.x, lane = tid & 63, wave = __builtin_amdgcn_readfirstlane(tid >> 6);
    const int G = gridDim.x, bx = blockIdx.x, vcu = (G % 8 == 0) ? (bx % 8) * (G / 8) + bx / 8 : bx;
    const float *x = args.in[0], *cvec = args.in[1], *w_ada = args.in[2], *b_ada = args.in[3], *g_pre = args.in[4], *w_in = args.in[5], *conv_w = args.in[6], *conv_b = args.in[7],
                *g_conv = args.in[8], *g_attn = args.in[9], *w_out = args.in[10], *g_post = args.in[11];
    unsigned char* ws = args.ws;
    float* modp = (float*)(ws + WS_MODP); float* gate = (float*)(ws + WS_GATE); float* ssqa = (float*)(ws + WS_SSQA); float* ssqy = (float*)(ws + WS_SSQY);
    bf16_t* woutT = (bf16_t*)(ws + WS_WOUTT); bf16_t* winT = (bf16_t*)(ws + WS_WINT); bf16_t* obuf = (bf16_t*)(ws + WS_O); bf16_t* hbuf = (bf16_t*)(ws + WS_H);
    bf16_t* ycat = (bf16_t*)(ws + WS_YCAT); bf16_t* proj = (bf16_t*)(ws + WS_PROJ); bf16_t* ybuf = (bf16_t*)(ws + WS_Y); bf16_t* qkv = (bf16_t*)(ws + WS_QKV);
    const int lo = args.ph_lo, hi = args.ph_hi;
    const int gw = bx * NWAVES + wave, NGW = G * NWAVES;
#define IN(k) (lo <= (k) && (k) < hi)
#define SEAM(k) do { if (IN(k) && IN((k) + 1)) { cg::this_grid().sync(); } } while (0)

    if (IN(0)) {
        LAS float* scr = (LAS float*)(lds + wave * 16384);
        constexpr int I_MOD = KSPLIT * 48, I_IN = (DM / 64) * (NPROJ / 32), I_OUT = (DM / 64) * (DM / 32);
        for (int it = gw; it < I_MOD + I_IN + I_OUT; it += NGW) {
            if (it < I_MOD) p0_mod_item(cvec, w_ada, modp, scr, it, lane);
            else if (it < I_MOD + I_IN) p0_transpose_item(w_in, DM, NPROJ, winT, scr, it - I_MOD, lane);
            else p0_transpose_item(w_out, DM, DM, woutT, scr, it - I_MOD - I_IN, lane);
        }
    }
    SEAM(0);
    if (IN(1)) p1_rows(x, b_ada, g_pre, modp, gate, hbuf, lds, bx, G, tid, wave, lane);
    SEAM(1);
    if (IN(2)) {
        pg8::Gemm g{hbuf, winT, MTOK, NPROJ, DM}; pg8::StaticOrder S; S.init(MTOK, NPROJ, G, bx);
        pg8::EpiProj E{proj, qkv};
        pg8::gemm_phase<pg8::EpiProj, pg8::StaticOrder, PG8_ALIGN, PG8_SP2>(lds, g, S, E);
    }
    SEAM(2);
    if (IN(3)) {
        for (int it = vcu; it < NATT + MTOK / 64; it += G) {
            if (it < NATT) {
#if ATTN_NAIVE
                attn_naive_item(qkv, obuf, ssqa, it, tid);
#else
                attn_unit(qkv, obuf, ssqa, lds, it, wave, lane);
#endif
            } else conv_unit(proj, conv_w, conv_b, g_conv, ycat, it - NATT, wave, lane);
        }
    }
    SEAM(3);
    if (IN(4)) {
        for (int row = gw; row < MTOK; row += NGW) {
            const float sv = lane < NH ? ssqa[(size_t)row * NH + lane] : 0.f;
            const float rstd = 1.0f / sqrtf(wave_sum(sv) * (1.0f / DG) + EPS);
            float ov[16], zv[16], g[16];
            load16(obuf + (size_t)row * DG, lane, ov); load16(proj + (size_t)row * NPROJ + OFF_ZA, lane, zv); load16f(g_attn, lane, g);
#pragma unroll
            for (int e = 0; e < 16; ++e) ov[e] = ov[e] * rstd * g[e] * silu_f(zv[e]);
            store16(ycat + (size_t)row * DM + DG, lane, ov);
        }
    }
    SEAM(4);
    if (IN(5)) {
        pg8::Gemm g{ycat, woutT, MTOK, DM, DM}; pg8::StaticOrder S; S.init(MTOK, DM, G, bx);
        pg8::EpiY E{ybuf, DM, ssqy};
        pg8::gemm_phase<pg8::EpiY, pg8::StaticOrder, PG8_ALIGN, PG8_SP2>(lds, g, S, E);
    }
    SEAM(5);
    if (IN(6)) {
        for (int row = gw; row < MTOK; row += NGW) {
            const int b = row >> 11;
            const float sv = lane < 32 ? ssqy[(size_t)row * 32 + lane] : 0.f;
            const float rstd = 1.0f / sqrtf(wave_sum(sv) * (1.0f / DM) + EPS);
#pragma unroll
            for (int j = 0; j < 4; ++j) { const int c = 512 * j + 8 * lane; const size_t off = (size_t)row * DM + c;
                const u32x4 yw = *(const u32x4*)(ybuf + off); float yv[8]; unpack8(yw, yv);
                const f32x4 x0 = *(const f32x4*)(x + off), x1 = *(const f32x4*)(x + off + 4), g0 = *(const f32x4*)(gate + b * DM + c), g1 = *(const f32x4*)(gate + b * DM + c + 4),
                            p0 = *(const f32x4*)(g_post + c), p1 = *(const f32x4*)(g_post + c + 4);
                f32x4 o0, o1;
#pragma unroll
                for (int e = 0; e < 4; ++e) { o0[e] = x0[e] + g0[e] * p0[e] * (yv[e] * rstd); o1[e] = x1[e] + g1[e] * p1[e] * (yv[4 + e] * rstd); }
                *(f32x4*)(args.out + off) = o0; *(f32x4*)(args.out + off + 4) = o1; }
        }
    }
#undef IN
#undef SEAM
}

extern "C" void kernel_launch(void* const* d_in, const int* in_sizes, int n_in, void* d_out, int out_size, void* d_ws, size_t ws_size, hipStream_t stream) {
    static int grid = 0;
    if (grid == 0) {
        if (n_in != 12 || in_sizes[0] != MTOK * DM || out_size != MTOK * DM || ws_size < WS_END) { fprintf(stderr, "kernel_launch: unexpected problem (n_in %d, in0 %d, out %d, ws %zu); nothing launched\n", n_in, n_in > 0 ? in_sizes[0] : -1, out_size, ws_size); grid = -1; return; }
        int dev = 0, cus = 0, per_cu = 0;
        if (hipGetDevice(&dev) != hipSuccess || hipDeviceGetAttribute(&cus, hipDeviceAttributeMultiprocessorCount, dev) != hipSuccess) { grid = -1; return; }
        if (hipFuncSetAttribute((const void*)mk_fwd, hipFuncAttributeMaxDynamicSharedMemorySize, LDS_BYTES) != hipSuccess) { fprintf(stderr, "kernel_launch: hipFuncSetAttribute failed\n"); grid = -1; return; }
        if (hipOccupancyMaxActiveBlocksPerMultiprocessor(&per_cu, (const void*)mk_fwd, NWAVES * 64, LDS_BYTES) != hipSuccess || per_cu < 1) { fprintf(stderr, "kernel_launch: occupancy query says %d blocks per CU\n", per_cu); (void)hipGetLastError(); grid = -1; return; }
        grid = cus * per_cu;
    }
    if (grid < 0) return;
    Args a{};
    for (int i = 0; i < 12; ++i) a.in[i] = (const float*)d_in[i];
    a.out = (float*)d_out; a.ws = (unsigned char*)d_ws;
#if MK_N_LAUNCHES == 1
    a.ph_lo = 0; a.ph_hi = NPHASE;
    void* kargs[] = {&a};
    hipError_t e = hipLaunchCooperativeKernel((const void*)mk_fwd, dim3(grid), dim3(NWAVES * 64), kargs, LDS_BYTES, stream);
    if (e != hipSuccess) fprintf(stderr, "kernel_launch: cooperative launch failed: %s (grid %d)\n", hipGetErrorString(e), grid);
#else
    for (int p = 0; p < NPHASE; ++p) { a.ph_lo = p; a.ph_hi = p + 1; hipLaunchKernelGGL(mk_fwd, dim3(grid), dim3(NWAVES * 64), LDS_BYTES, stream, a); }
#endif
}
```

```cpp
#include <hip/hip_runtime.h>
#include <hip/hip_cooperative_groups.h>
#include <cstdio>
#include <cstdint>
namespace cg = cooperative_groups;
namespace pg8 {
#define PG8_LAS __attribute__((address_space(3)))
typedef unsigned short bf16_t;
typedef short bf16x8 __attribute__((ext_vector_type(8)));
typedef float f32x4 __attribute__((ext_vector_type(4)));
typedef unsigned u32x4 __attribute__((ext_vector_type(4)));
constexpr int BM = 256, BK = 64, HALF = 128, HTB = HALF * BK * 2  , STAGE_BYTES = 8 * HTB, NXCD = 8, WGM = 8;

__host__ __device__ __forceinline__ int lds_byte(int r, int c) { const int st = (r >> 4) * 2 + (c >> 5), rr = r & 15, cc = c & 31, ob = rr * 64 + cc * 2; return st * 1024 + (ob ^ (((ob >> 9) & 1) << 5)); }
__host__ __device__ __forceinline__ void stage_rc(int b, int& R, int& C) { const int st = b / 1024, sb = b % 1024, swz = sb ^ (((sb >> 9) & 1) << 5); R = (st >> 1) * 16 + swz / 64; C = (st & 1) * 32 + (swz % 64) / 2; }
__host__ __device__ __forceinline__ int perm32(int rho) { const int n = rho >> 4, i = rho & 15; return 8 * (i >> 2) + 4 * n + (i & 3); }

struct Unit { int pm, pn; };
struct Gemm { const bf16_t* A; const bf16_t* Bt; int M, N, K; };

struct StaticOrder {
    int nM, nN, nwg, G, c;
    __host__ __device__ void init(int M, int N, int G_, int c_) { nM = M / BM; nN = N / BM; nwg = nM * nN; G = G_; c = c_; }
    __host__ __device__ bool next(int i, Unit& u) const {
        const long L = (long)i * G + c; if (L >= nwg) return false;
        int wgid = (int)L; { const int q = nwg / NXCD, r = nwg % NXCD, xcd = wgid % NXCD, off = wgid / NXCD; wgid = (xcd < r ? xcd * (q + 1) : r * (q + 1) + (xcd - r) * q) + off; }
        const int nig = WGM * nN, gid = wgid / nig, fm = gid * WGM, gsz = (nM - fm) < WGM ? (nM - fm) : WGM;
        u.pm = fm + ((wgid % nig) % gsz); u.pn = (wgid % nig) / gsz; return true;
    }
    __device__ __forceinline__ void a_ready(const Unit&) const {}
    __device__ __forceinline__ void done(const Unit&) const {}
};

__device__ __forceinline__ unsigned cvt_pk_bf16(float lo, float hi) { unsigned r; asm volatile("v_cvt_pk_bf16_f32 %0, %1, %2" : "=v"(r) : "v"(lo), "v"(hi)); return r; }
typedef float f32x2 __attribute__((ext_vector_type(2)));
__device__ __forceinline__ f32x2 gelu_pk(f32x2 v) {
    const f32x2 av = __builtin_elementwise_abs(v), d = av * 0.2316418882f + 1.0f;
    f32x2 t; t.x = __builtin_amdgcn_rcpf(d.x); t.y = __builtin_amdgcn_rcpf(d.y);
    f32x2 q = t * 0.5307027145f + (-0.7265760135f); q = q * t + 0.7107068705f; q = q * t + (-0.142248368f); q = q * t + 0.127414796f; q = q * t;
    const f32x2 s = (v * v) * (-0.72134752044f);
    f32x2 e; e.x = __builtin_amdgcn_exp2f(s.x); e.y = __builtin_amdgcn_exp2f(s.y);
    const f32x2 m = v * (q * e), r = v - m;
    f32x2 o; o.x = v.x < 0.f ? m.x : r.x; o.y = v.y < 0.f ? m.y : r.y; return o;
}

template <int ACT  > struct EpiBf16 {
    static constexpr bool PERM = true, AFTER_DRAIN = false; static_assert(ACT == 0 || ACT == 1, "EpiBf16: ACT is 0 (none) or 1 (gelu_pk)");
    bf16_t* O; int ldc; const float* bias; int split_cols; size_t split_stride; float scale0;
    __device__ __forceinline__ void operator()(const f32x4 (&acc)[2][2][4][2], const Unit& u, int wr, int wc, int fr, int fq) const {
        const int row0 = u.pm * BM + wr * 64 + fr; int colt = u.pn * BM; bf16_t* base = O;
        float sc = 1.f; if (split_cols) { const int t = colt / split_cols; base += (size_t)t * split_stride; colt -= t * split_cols; if (t == 0) sc = scale0; }
        const int col0 = colt + wc * 32 + 8 * fq, bcol0 = u.pn * BM + wc * 32 + 8 * fq;
        f32x4 bv[2][2];
#pragma unroll
        for (int bj = 0; bj < 2; ++bj)
#pragma unroll
            for (int n = 0; n < 2; ++n) bv[bj][n] = bias ? *(const f32x4*)(bias + bcol0 + bj * HALF + 4 * n) : (f32x4){0.f, 0.f, 0.f, 0.f};
#pragma unroll
        for (int ai = 0; ai < 2; ++ai)
#pragma unroll
            for (int m = 0; m < 4; ++m) { bf16_t* rowp = base + (size_t)(row0 + ai * HALF + m * 16) * ldc + col0;
#pragma unroll
                for (int bj = 0; bj < 2; ++bj) { f32x4 v0 = acc[ai][bj][m][0] + bv[bj][0], v1 = acc[ai][bj][m][1] + bv[bj][1];
                    if (ACT == 1) { f32x2 a = gelu_pk((f32x2){v0[0], v0[1]}), b = gelu_pk((f32x2){v0[2], v0[3]}), c = gelu_pk((f32x2){v1[0], v1[1]}), d = gelu_pk((f32x2){v1[2], v1[3]});
                        v0 = (f32x4){a.x, a.y, b.x, b.y}; v1 = (f32x4){c.x, c.y, d.x, d.y}; }
                    v0 = v0 * sc; v1 = v1 * sc; u32x4 w; w.x = cvt_pk_bf16(v0[0], v0[1]); w.y = cvt_pk_bf16(v0[2], v0[3]); w.z = cvt_pk_bf16(v1[0], v1[1]); w.w = cvt_pk_bf16(v1[2], v1[3]);
                    *(u32x4*)(rowp + bj * HALF) = w; } }
    }
};
struct EpiY {
    static constexpr bool PERM = true, AFTER_DRAIN = false;
    bf16_t* Y; int ldc; float* ssq;
    __device__ __forceinline__ void operator()(const f32x4 (&acc)[2][2][4][2], const Unit& u, int wr, int wc, int fr, int fq) const {
        const int row0 = u.pm * BM + wr * 64 + fr; const int col0 = u.pn * BM + wc * 32 + 8 * fq;
#pragma unroll
        for (int ai = 0; ai < 2; ++ai)
#pragma unroll
            for (int m = 0; m < 4; ++m) { const int row = row0 + ai * HALF + m * 16; bf16_t* rowp = Y + (size_t)row * ldc + col0; float ss = 0.f;
#pragma unroll
                for (int bj = 0; bj < 2; ++bj) { const f32x4 v0 = acc[ai][bj][m][0], v1 = acc[ai][bj][m][1];
                    ss += (v0[0] * v0[0] + v0[1] * v0[1]) + (v0[2] * v0[2] + v0[3] * v0[3]) + (v1[0] * v1[0] + v1[1] * v1[1]) + (v1[2] * v1[2] + v1[3] * v1[3]);
                    u32x4 w; w.x = cvt_pk_bf16(v0[0], v0[1]); w.y = cvt_pk_bf16(v0[2], v0[3]); w.z = cvt_pk_bf16(v1[0], v1[1]); w.w = cvt_pk_bf16(v1[2], v1[3]);
                    *(u32x4*)(rowp + bj * HALF) = w; }
                ss += __shfl_xor(ss, 16); ss += __shfl_xor(ss, 32);
                if (fq == 0) ssq[(size_t)row * 32 + u.pn * 4 + wc] = ss; }
    }
};
struct EpiProj {
    static constexpr bool PERM = true, AFTER_DRAIN = false;
    bf16_t* P; bf16_t* QKV;
    __device__ __forceinline__ void operator()(const f32x4 (&acc)[2][2][4][2], const Unit& u, int wr, int wc, int fr, int fq) const {
        const int row0 = u.pm * BM + wr * 64 + fr, colt = u.pn * BM;
        if (colt < 4096 || colt >= 7168) {
            const int col0 = (colt < 4096 ? colt : colt - 3072) + wc * 32 + 8 * fq;
#pragma unroll
            for (int ai = 0; ai < 2; ++ai)
#pragma unroll
                for (int m = 0; m < 4; ++m) { bf16_t* rowp = P + (size_t)(row0 + ai * HALF + m * 16) * 5120 + col0;
#pragma unroll
                    for (int bj = 0; bj < 2; ++bj) { const f32x4 v0 = acc[ai][bj][m][0], v1 = acc[ai][bj][m][1];
                        u32x4 w; w.x = cvt_pk_bf16(v0[0], v0[1]); w.y = cvt_pk_bf16(v0[2], v0[3]); w.z = cvt_pk_bf16(v1[0], v1[1]); w.w = cvt_pk_bf16(v1[2], v1[3]);
                        *(u32x4*)(rowp + bj * HALF) = w; } }
        } else {
            const int which = (colt - 4096) >> 10, cin = ((colt - 4096) & 1023) + wc * 32 + 8 * fq;
            bf16_t* base = QKV + (size_t)which * (16384u * 1024u);
#pragma unroll
            for (int ai = 0; ai < 2; ++ai)
#pragma unroll
                for (int m = 0; m < 4; ++m) { const int row = row0 + ai * HALF + m * 16, b = row >> 11, t = row & 2047;
#pragma unroll
                    for (int bj = 0; bj < 2; ++bj) { const int c = cin + bj * HALF, head = c >> 6, d = c & 63;
                        const f32x4 v0 = acc[ai][bj][m][0], v1 = acc[ai][bj][m][1];
                        u32x4 w; w.x = cvt_pk_bf16(v0[0], v0[1]); w.y = cvt_pk_bf16(v0[2], v0[3]); w.z = cvt_pk_bf16(v1[0], v1[1]); w.w = cvt_pk_bf16(v1[2], v1[3]);
                        *(u32x4*)(base + ((size_t)((b * 16 + head) * 2048 + t)) * 64 + d) = w; } }
        }
    }
};
template <class Epi, class Sched, bool ALIGN_EPI = false, bool SP2 = false>
__device__ __forceinline__ void gemm_phase(PG8_LAS unsigned char* lds, const Gemm g, const Sched& S, const Epi& E) {
    const int tid = threadIdx.x, wid = __builtin_amdgcn_readfirstlane(tid >> 6), lane = tid & 63, wr = wid >> 2, wc = wid & 3, fr = lane & 15, fq = lane >> 4;
    const int K = g.K, nt = K / BK;
    unsigned voffA[2], voffB[2];
#pragma unroll
    for (int i = 0; i < 2; ++i) { int R, C; stage_rc(tid * 16 + i * 8192, R, C); const int Rb = Epi::PERM ? ((R & ~31) + perm32(R & 31)) : R;
        voffA[i] = (unsigned)(R * K + C) * 2u; voffB[i] = (unsigned)(Rb * K + C) * 2u; }
    const size_t kstep = (size_t)(BK * 2);
    const size_t hstep = (size_t)HALF * K * 2;
    const size_t tstep = 2 * hstep;
    const unsigned ldsw = (unsigned)wid * 1024u;
    const int aoff = lds_byte(wr * 64 + fr, fq * 8), boff = lds_byte(wc * 32 + fr, fq * 8);
#define PG8_SA(b, h) (((b) * 2 + (h)) * HTB)
#define PG8_SB(b, h) ((4 + (b) * 2 + (h)) * HTB)
#define PG8_STAGE(bufoff, gbase, voff) do { _Pragma("unroll") for (int _i = 0; _i < 2; ++_i) \
        __builtin_amdgcn_global_load_lds((const unsigned*)((const char*)(gbase) + (voff)[_i]), (PG8_LAS unsigned*)(lds + (bufoff) + ldsw + _i * 8192), 16, 0, 0); } while (0)
#define PG8_LDA(dst, b, h) do { _Pragma("unroll") for (int m = 0; m < 4; ++m) _Pragma("unroll") for (int k = 0; k < 2; ++k) dst[m][k] = *(const PG8_LAS bf16x8*)(lds + PG8_SA(b, h) + aoff + m * 2048 + k * 1024); } while (0)
#define PG8_LDB(dst, b, h) do { _Pragma("unroll") for (int n = 0; n < 2; ++n) _Pragma("unroll") for (int k = 0; k < 2; ++k) dst[n][k] = *(const PG8_LAS bf16x8*)(lds + PG8_SB(b, h) + boff + n * 2048 + k * 1024); } while (0)
#define PG8_MMA(ai, bj, At, Bt) do { __builtin_amdgcn_s_setprio(1); _Pragma("unroll") for (int m = 0; m < 4; ++m) _Pragma("unroll") for (int n = 0; n < 2; ++n) _Pragma("unroll") for (int k = 0; k < 2; ++k) \
        acc[ai][bj][m][n] = __builtin_amdgcn_mfma_f32_16x16x32_bf16(Bt[n][k], At[m][k], acc[ai][bj][m][n], 0, 0, 0); __builtin_amdgcn_s_setprio(0); } while (0)
#define PG8_WAIT_V(n) asm volatile("s_waitcnt vmcnt(" #n ")" ::: "memory")
#define PG8_WAIT_L(n) asm volatile("s_waitcnt lgkmcnt(" #n ")" ::: "memory")
#define PG8_BAR __builtin_amdgcn_s_barrier()
#define PG8_SCHED __builtin_amdgcn_sched_barrier(0)
    Unit cur, nxt; int ui = 0;
    if (!S.next(0, cur)) return;
    f32x4 acc[2][2][4][2];
#pragma unroll
    for (int a = 0; a < 2; ++a)
#pragma unroll
        for (int b = 0; b < 2; ++b)
#pragma unroll
            for (int m = 0; m < 4; ++m)
#pragma unroll
                for (int n = 0; n < 2; ++n) acc[a][b][m][n] = (f32x4){0.f, 0.f, 0.f, 0.f};
    bf16x8 At[4][2], B0[2][2], B1[2][2];
    const char* cA = (const char*)g.A + (size_t)cur.pm * tstep; const char* cB = (const char*)g.Bt + (size_t)cur.pn * tstep;
    S.a_ready(cur);
    if constexpr (SP2) {
        PG8_STAGE(PG8_SB(0, 0), cB, voffB); PG8_STAGE(PG8_SB(0, 1), cB + hstep, voffB); PG8_STAGE(PG8_SA(0, 0), cA, voffA); PG8_STAGE(PG8_SA(0, 1), cA + hstep, voffA);
        if (wr == 1) PG8_BAR;
        PG8_WAIT_V(2); PG8_BAR;
        PG8_STAGE(PG8_SB(1, 0), cB + kstep, voffB); PG8_STAGE(PG8_SA(1, 0), cA + kstep, voffA); PG8_STAGE(PG8_SB(1, 1), cB + hstep + kstep, voffB);
        PG8_WAIT_V(6); PG8_BAR;
    } else {
        PG8_STAGE(PG8_SB(0, 0), cB, voffB); PG8_STAGE(PG8_SA(0, 0), cA, voffA); PG8_STAGE(PG8_SB(0, 1), cB + hstep, voffB); PG8_STAGE(PG8_SA(0, 1), cA + hstep, voffA);
        if (wr == 1) PG8_BAR;
        PG8_WAIT_V(4); PG8_BAR;
        PG8_STAGE(PG8_SB(1, 0), cB + kstep, voffB); PG8_STAGE(PG8_SA(1, 0), cA + kstep, voffA); PG8_STAGE(PG8_SB(1, 1), cB + hstep + kstep, voffB);
        PG8_WAIT_V(6); PG8_BAR;
    }
    for (;;) {
        const bool has_next = S.next(ui + 1, nxt);
        const char* nA = has_next ? (const char*)g.A + (size_t)nxt.pm * tstep : cA; const char* nB = has_next ? (const char*)g.Bt + (size_t)nxt.pn * tstep : cB;
        for (int t = 0; t < nt; t += 2) {
            const bool last = (t == nt - 2);
            const char* a1 = cA + (size_t)(t + 1) * kstep;
            const char* a2 = last ? nA : cA + (size_t)(t + 2) * kstep; const char* b2 = last ? nB : cB + (size_t)(t + 2) * kstep;
            const char* a3 = a2 + kstep; const char* b3 = b2 + kstep;
            if (last && has_next) S.a_ready(nxt);
            if constexpr (SP2) {
            PG8_LDB(B0, 0, 0); PG8_LDB(B1, 0, 1); PG8_SCHED; PG8_LDA(At, 0, 0); PG8_STAGE(PG8_SA(1, 1), a1 + hstep, voffA);
            PG8_WAIT_V(8); PG8_WAIT_L(0); PG8_BAR; PG8_MMA(0, 0, At, B0); PG8_MMA(0, 1, At, B1); PG8_BAR; PG8_SCHED;
            PG8_LDA(At, 0, 1); PG8_STAGE(PG8_SB(0, 0), b2, voffB); PG8_STAGE(PG8_SB(0, 1), b2 + hstep, voffB); PG8_STAGE(PG8_SA(0, 0), a2, voffA);
            PG8_WAIT_V(8); PG8_WAIT_L(0); PG8_BAR; PG8_MMA(1, 0, At, B0); PG8_MMA(1, 1, At, B1); PG8_BAR; PG8_SCHED;
            PG8_LDB(B0, 1, 0); PG8_LDB(B1, 1, 1); PG8_SCHED; PG8_LDA(At, 1, 0); PG8_STAGE(PG8_SA(0, 1), a2 + hstep, voffA);
            PG8_WAIT_V(8); PG8_WAIT_L(0); PG8_BAR; PG8_MMA(0, 0, At, B0); PG8_MMA(0, 1, At, B1); PG8_BAR; PG8_SCHED;
            PG8_LDA(At, 1, 1); PG8_STAGE(PG8_SB(1, 0), b3, voffB); PG8_STAGE(PG8_SB(1, 1), b3 + hstep, voffB); PG8_STAGE(PG8_SA(1, 0), a3, voffA);
            PG8_WAIT_V(8); PG8_WAIT_L(0); PG8_BAR; PG8_MMA(1, 0, At, B0); PG8_MMA(1, 1, At, B1); PG8_BAR; PG8_SCHED;
            } else {
            PG8_LDB(B0, 0, 0); PG8_SCHED; PG8_LDA(At, 0, 0); PG8_STAGE(PG8_SA(1, 1), a1 + hstep, voffA);
            PG8_WAIT_L(8); PG8_BAR; PG8_WAIT_L(0); PG8_MMA(0, 0, At, B0); PG8_BAR; PG8_SCHED;
            PG8_LDB(B1, 0, 1); PG8_STAGE(PG8_SB(0, 0), b2, voffB);
            PG8_BAR; PG8_WAIT_L(0); PG8_MMA(0, 1, At, B1); PG8_BAR;
            PG8_LDA(At, 0, 1); PG8_STAGE(PG8_SA(0, 0), a2, voffA);
            PG8_BAR; PG8_WAIT_L(0); PG8_MMA(1, 0, At, B0); PG8_BAR; PG8_SCHED;
            PG8_STAGE(PG8_SB(0, 1), b2 + hstep, voffB);
            PG8_WAIT_V(6); PG8_BAR; PG8_MMA(1, 1, At, B1); PG8_BAR;
            PG8_LDB(B0, 1, 0); PG8_SCHED; PG8_LDA(At, 1, 0); PG8_STAGE(PG8_SA(0, 1), a2 + hstep, voffA);
            PG8_WAIT_L(8); PG8_BAR; PG8_WAIT_L(0); PG8_MMA(0, 0, At, B0); PG8_BAR; PG8_SCHED;
            PG8_LDB(B1, 1, 1); PG8_STAGE(PG8_SB(1, 0), b3, voffB);
            PG8_BAR; PG8_WAIT_L(0); PG8_MMA(0, 1, At, B1); PG8_BAR;
            PG8_LDA(At, 1, 1); PG8_STAGE(PG8_SA(1, 0), a3, voffA);
            PG8_BAR; PG8_WAIT_L(0); PG8_MMA(1, 0, At, B0); PG8_BAR; PG8_SCHED;
            PG8_STAGE(PG8_SB(1, 1), b3 + hstep, voffB);
            PG8_WAIT_V(6); PG8_BAR; PG8_MMA(1, 1, At, B1); PG8_BAR;
            }
        }
        if constexpr (ALIGN_EPI) { if (wr == 0) PG8_BAR; }
        if constexpr (!Epi::AFTER_DRAIN) { E(acc, cur, wr, wc, fr, fq); S.done(cur); }
        if (!has_next) break;
#pragma unroll
        for (int a = 0; a < 2; ++a)
#pragma unroll
            for (int b = 0; b < 2; ++b)
#pragma unroll
                for (int m = 0; m < 4; ++m)
#pragma unroll
                    for (int n = 0; n < 2; ++n) acc[a][b][m][n] = (f32x4){0.f, 0.f, 0.f, 0.f};
        cur = nxt; cA = nA; cB = nB; ++ui;
        if constexpr (ALIGN_EPI) { if (wr == 1) PG8_BAR; }
    }
    PG8_WAIT_V(0);
    if constexpr (!ALIGN_EPI) { if (wr == 0) PG8_BAR; }
    PG8_BAR;
    if constexpr (Epi::AFTER_DRAIN) { E.fused(acc, cur, wr, wc, fr, fq, lds, wid, lane); S.done(cur); }
#undef PG8_SA
#undef PG8_SB
#undef PG8_STAGE
#undef PG8_LDA
#undef PG8_LDB
#undef PG8_MMA
#undef PG8_WAIT_V
#undef PG8_WAIT_L
#undef PG8_BAR
#undef PG8_SCHED
}
}

#ifndef PG8_SP2
#define PG8_SP2 true
#endif
#ifndef PG8_ALIGN
#define PG8_ALIGN true
#endif
#ifndef MK_N_LAUNCHES
#define MK_N_LAUNCHES 1
#endif
#ifndef ATTN_NAIVE
#define ATTN_NAIVE 0
#endif

using pg8::bf16_t; using pg8::bf16x8; using pg8::f32x4; using pg8::u32x4;
typedef unsigned u32x2 __attribute__((ext_vector_type(2)));
typedef float f32x2 __attribute__((ext_vector_type(2)));
#define LAS __attribute__((address_space(3)))
constexpr int BATCH = 8, SEQ = 2048, DM = 2048, MTOK = BATCH * SEQ, NPROJ = 8192, DG = 1024, NH = 16, HD = 64, NMOD = 3 * DM;
constexpr int OFF_U = 0, OFF_B = 1024, OFF_C = 2048, OFF_ZC = 3072, OFF_Q = 4096, OFF_K = 5120, OFF_V = 6144, OFF_ZA = 7168;
constexpr float EPS = 1e-6f, LOG2E = 1.4426950408889634f;
constexpr int KSPLIT = 16, NWAVES = 8, NPHASE = 7;
constexpr size_t MiB = 1u << 20;
constexpr size_t WS_MODP = 1 * MiB, WS_GATE = 4 * MiB, WS_SSQY = 6 * MiB, WS_WOUTT = 8 * MiB, WS_WINT = 16 * MiB,
                 WS_H = 80 * MiB, WS_YCAT = WS_H  , WS_PROJ = 144 * MiB  , WS_Y = WS_PROJ  ,
                 WS_QKV = 304 * MiB  , WS_PARTO = 400 * MiB  , WS_LSE = 496 * MiB  , WS_END = 499 * MiB;
constexpr int PSTR = 5120, OFF_ZA5 = 4096;
constexpr int LDS_PHASE = 147456, LDS_BYTES = LDS_PHASE + 256;

#define LDS_WAIT() asm volatile("s_waitcnt lgkmcnt(0)" ::: "memory")
__device__ __forceinline__ float bf_lo(unsigned u) { return __uint_as_float(u << 16); }
__device__ __forceinline__ float bf_hi(unsigned u) { return __uint_as_float(u & 0xffff0000u); }
__device__ __forceinline__ unsigned pk(float lo, float hi) { return pg8::cvt_pk_bf16(lo, hi); }
__device__ __forceinline__ float silu_f(float v) { return v * __builtin_amdgcn_rcpf(1.f + __builtin_amdgcn_exp2f(-v * LOG2E)); }
__device__ __forceinline__ float wave_sum(float v) {
#pragma unroll
    for (int o = 1; o < 64; o <<= 1) v += __shfl_xor(v, o);
    return v;
}
__device__ __forceinline__ void unpack8(const u32x4 w, float* f) { f[0] = bf_lo(w.x); f[1] = bf_hi(w.x); f[2] = bf_lo(w.y); f[3] = bf_hi(w.y); f[4] = bf_lo(w.z); f[5] = bf_hi(w.z); f[6] = bf_lo(w.w); f[7] = bf_hi(w.w); }
__device__ __forceinline__ void load16(const bf16_t* rowp, int lane, float (&f)[16]) {
    const u32x4 a = *(const u32x4*)(rowp + 8 * lane), b = *(const u32x4*)(rowp + 512 + 8 * lane); unpack8(a, f); unpack8(b, f + 8);
}
__device__ __forceinline__ void load16f(const float* p, int lane, float (&f)[16]) {
#pragma unroll
    for (int j = 0; j < 2; ++j) { const f32x4 a = *(const f32x4*)(p + 512 * j + 8 * lane), b = *(const f32x4*)(p + 512 * j + 8 * lane + 4);
        f[8 * j + 0] = a[0]; f[8 * j + 1] = a[1]; f[8 * j + 2] = a[2]; f[8 * j + 3] = a[3]; f[8 * j + 4] = b[0]; f[8 * j + 5] = b[1]; f[8 * j + 6] = b[2]; f[8 * j + 7] = b[3]; }
}
__device__ __forceinline__ void store16(bf16_t* rowp, int lane, const float (&y)[16]) {
#pragma unroll
    for (int j = 0; j < 2; ++j) { u32x4 w; w.x = pk(y[8 * j + 0], y[8 * j + 1]); w.y = pk(y[8 * j + 2], y[8 * j + 3]); w.z = pk(y[8 * j + 4], y[8 * j + 5]); w.w = pk(y[8 * j + 6], y[8 * j + 7]);
        *(u32x4*)(rowp + 512 * j + 8 * lane) = w; }
}


typedef unsigned v4u __attribute__((ext_vector_type(4)));
#define XB_TMO      128
#define XB_XCNT(j)  (256  + 64 * (j))
#define XB_XSUB(j)  (1280 + 64 * (j))
#define XB_XGEN(j)  (2304 + 64 * (j))
#define XB_TOP      3328
#define XB_TOPGEN   3392
#define XCD_BAR_WORDS 3456
#define XB_SPIN_CAP (1u << 18)

__device__ __forceinline__ unsigned xb_ld(unsigned* p)              { return __hip_atomic_load(p, __ATOMIC_RELAXED, __HIP_MEMORY_SCOPE_AGENT); }
__device__ __forceinline__ unsigned xb_add(unsigned* p, unsigned v) { return __hip_atomic_fetch_add(p, v, __ATOMIC_RELAXED, __HIP_MEMORY_SCOPE_AGENT); }
__device__ __forceinline__ unsigned xb_xcc_id() { return (unsigned)__builtin_amdgcn_s_getreg((3 << 11) | 20) & 0xFu; }
#define XB_SPIN(cond, bar) do { unsigned _sp = 0; while (cond) { __builtin_amdgcn_s_sleep(1); \
    if ((++_sp & 255u) == 0u) { if (xb_ld(&(bar)[XB_TMO])) break; if (_sp > XB_SPIN_CAP) { atomicAdd(&(bar)[XB_TMO], 1u); break; } } } } while (0)

struct XcdBarrier {
    unsigned* bar; unsigned x;
    volatile LAS unsigned* st;
};

__device__ __forceinline__ XcdBarrier xcd_barrier_post(unsigned* bar, volatile LAS unsigned* st) {
    XcdBarrier b; b.bar = bar; b.x = xb_xcc_id(); b.st = st;
    if (threadIdx.x == 0) (void)xb_add(&bar[XB_XCNT(b.x)], 1u);
    return b;
}
__device__ __forceinline__ void xcd_barrier_complete(unsigned* bar, unsigned x, unsigned& nloc, unsigned& nx) {
    const unsigned G = gridDim.x * gridDim.y * gridDim.z;
    unsigned sum, cnt, mine, sp = 0u;
    for (;;) {
        sum = 0u; cnt = 0u; mine = 0u;
#pragma unroll
        for (unsigned j = 0; j < 16; ++j) { const unsigned c = xb_ld(&bar[XB_XCNT(j)]); sum += c; cnt += (c > 0u) ? 1u : 0u; mine = (j == x) ? c : mine; }
        if (sum == G) break;
        __builtin_amdgcn_s_sleep(1);
        if ((++sp & 255u) == 0u) { if (xb_ld(&bar[XB_TMO])) break; if (sp > XB_SPIN_CAP) { atomicAdd(&bar[XB_TMO], 1u); break; } }
    }
    nloc = mine > 0u ? mine : 1u; nx = cnt > 0u ? cnt : 1u;
}

__device__ __forceinline__ void xcd_barrier(const XcdBarrier& b) {
    asm volatile("s_waitcnt vmcnt(0)" ::: "memory");
    __syncthreads();
    if (threadIdx.x == 0) {
        unsigned* bar = b.bar;
        __builtin_amdgcn_s_waitcnt(0);
        unsigned nloc = b.st[0], nx = b.st[1];
        if (nloc == 0u) { xcd_barrier_complete(bar, b.x, nloc, nx); b.st[0] = nloc; b.st[1] = nx; }
        const unsigned old = xb_add(&bar[XB_XSUB(b.x)], 1u);
        const unsigned gen = old / nloc;
        if (old + 1u == (gen + 1u) * nloc) {
            __builtin_amdgcn_fence(__ATOMIC_RELEASE, "agent");
            asm volatile("s_waitcnt vmcnt(0)" ::: "memory");
            const unsigned og = xb_add(&bar[XB_TOP], 1u);
            const unsigned tg = og / nx;
            if (og + 1u == (tg + 1u) * nx) xb_add(&bar[XB_TOPGEN], 1u);
            else XB_SPIN(xb_ld(&bar[XB_TOPGEN]) == tg, bar);
            __builtin_amdgcn_fence(__ATOMIC_ACQUIRE, "agent");
            xb_add(&bar[XB_XGEN(b.x)], 1u);
            asm volatile("s_waitcnt vmcnt(0)" ::: "memory");
        } else {
            XB_SPIN(xb_ld(&bar[XB_XGEN(b.x)]) == gen, bar);
            __builtin_amdgcn_fence(__ATOMIC_ACQUIRE, "agent");
            asm volatile("s_waitcnt vmcnt(0)" ::: "memory");
        }
    }
    __syncthreads();
}

__device__ __forceinline__ void p0_transpose_item(const float* __restrict__ W, int K, int N, bf16_t* __restrict__ WT, LAS float* scr, int item, int lane) {
    const int nblk = N / 32, kb = item / nblk, nb = item % nblk, k0 = 64 * kb, n0 = 32 * nb;
#pragma unroll 8
    for (int i = 0; i < 32; ++i) { const int kk = 2 * i + (lane >> 5); scr[kk * 33 + (lane & 31)] = W[(size_t)(k0 + kk) * N + n0 + (lane & 31)]; }
    LDS_WAIT();
    const int c = lane & 7;
#pragma unroll
    for (int j = 0; j < 4; ++j) { const int n = (lane >> 3) + 8 * j; const LAS float* s = scr + (8 * c) * 33 + n;
        u32x4 o; o.x = pk(s[0 * 33], s[1 * 33]); o.y = pk(s[2 * 33], s[3 * 33]); o.z = pk(s[4 * 33], s[5 * 33]); o.w = pk(s[6 * 33], s[7 * 33]);
        *(u32x4*)(WT + (size_t)(n0 + n) * K + k0 + 8 * c) = o; }
    LDS_WAIT();
}
__device__ __forceinline__ void p0_mod_item(const float* __restrict__ cvec, const float* __restrict__ wada, float* __restrict__ modp, LAS float* scr, int item, int lane) {
    const int kc = item / 48, nc = item % 48, k0 = kc * 128, n0 = nc * 128;
#pragma unroll
    for (int i = 0; i < 16; ++i) { const int idx = i * 64 + lane, b = idx >> 7, kk = idx & 127; scr[kk * 8 + b] = silu_f(cvec[b * DM + k0 + kk]); }
    LDS_WAIT();
    float acc[8][2];
#pragma unroll
    for (int b = 0; b < 8; ++b) { acc[b][0] = 0.f; acc[b][1] = 0.f; }
    const float* wp = wada + (size_t)k0 * NMOD + n0 + 2 * lane;
#pragma unroll 8
    for (int kk = 0; kk < 128; ++kk) {
        const f32x2 w = *(const f32x2*)(wp + (size_t)kk * NMOD);
        const f32x4 s0 = *(const LAS f32x4*)(scr + kk * 8), s1 = *(const LAS f32x4*)(scr + kk * 8 + 4);
        acc[0][0] += s0[0] * w[0]; acc[0][1] += s0[0] * w[1]; acc[1][0] += s0[1] * w[0]; acc[1][1] += s0[1] * w[1];
        acc[2][0] += s0[2] * w[0]; acc[2][1] += s0[2] * w[1]; acc[3][0] += s0[3] * w[0]; acc[3][1] += s0[3] * w[1];
        acc[4][0] += s1[0] * w[0]; acc[4][1] += s1[0] * w[1]; acc[5][0] += s1[1] * w[0]; acc[5][1] += s1[1] * w[1];
        acc[6][0] += s1[2] * w[0]; acc[6][1] += s1[2] * w[1]; acc[7][0] += s1[3] * w[0]; acc[7][1] += s1[3] * w[1];
    }
#pragma unroll
    for (int b = 0; b < 8; ++b) *(f32x2*)(modp + ((size_t)kc * 8 + b) * NMOD + n0 + 2 * lane) = (f32x2){acc[b][0], acc[b][1]};
    LDS_WAIT();
}

__device__ __forceinline__ void p1_rows(const float* __restrict__ x, const float* __restrict__ b_ada, const float* __restrict__ g_pre, const float* __restrict__ modp,
                                        float* __restrict__ gate, bf16_t* __restrict__ hbuf, LAS unsigned char* lds, int bx, int G, int tid, int wave, int lane) {
    LAS float* Ac = (LAS float*)lds; LAS float* Sc = Ac + DM;
    for (int chunk = bx; chunk < MTOK / 64; chunk += G) {
        const int b = chunk >> 5;
        __syncthreads();
        { const int d = tid * 4;
          f32x4 sh = *(const f32x4*)(b_ada + d), sc = *(const f32x4*)(b_ada + DM + d);
#pragma unroll 4
          for (int kc = 0; kc < KSPLIT; ++kc) { const float* p = modp + ((size_t)kc * 8 + b) * NMOD + d; sh += *(const f32x4*)p; sc += *(const f32x4*)(p + DM); }
          const f32x4 g = *(const f32x4*)(g_pre + d);
          *(LAS f32x4*)(Ac + d) = g * (sc + 1.0f); *(LAS f32x4*)(Sc + d) = sh;
          if ((chunk & 31) == 0) { f32x4 gt = *(const f32x4*)(b_ada + 2 * DM + d);
#pragma unroll 4
              for (int kc = 0; kc < KSPLIT; ++kc) gt += *(const f32x4*)(modp + ((size_t)kc * 8 + b) * NMOD + 2 * DM + d);
              *(f32x4*)(gate + b * DM + d) = gt; } }
        __syncthreads();
        for (int i = 0; i < 8; ++i) {
            const int row = chunk * 64 + wave * 8 + i;
            const f32x4* xr = (const f32x4*)(x + (size_t)row * DM) + lane;
            f32x4 v[8]; float s = 0.f;
#pragma unroll
            for (int j = 0; j < 8; ++j) { v[j] = xr[64 * j]; s += (v[j][0] * v[j][0] + v[j][1] * v[j][1]) + (v[j][2] * v[j][2] + v[j][3] * v[j][3]); }
            const float rstd = 1.0f / sqrtf(wave_sum(s) * (1.0f / DM) + EPS);
            u32x2* o8 = (u32x2*)(hbuf + (size_t)row * DM) + lane;
#pragma unroll
            for (int j = 0; j < 8; ++j) { const int d = 4 * lane + 256 * j; const f32x4 a = *(const LAS f32x4*)(Ac + d), sft = *(const LAS f32x4*)(Sc + d);
                const f32x4 o = v[j] * rstd * a + sft; u32x2 w; w.x = pk(o[0], o[1]); w.y = pk(o[2], o[3]); o8[64 * j] = w; }
        }
    }
}

__device__ __forceinline__ void conv_unit(const bf16_t* __restrict__ proj, const float* __restrict__ cw, const float* __restrict__ cb, const float* __restrict__ gc,
                                          bf16_t* __restrict__ ycat, int unit, int wave, int lane) {
    const int tk0 = unit * 64 + wave * 8, t0 = tk0 & (SEQ - 1);
    float w0[16], w1[16], w2[16], bb[16];
    load16f(cw, lane, w0); load16f(cw + DG, lane, w1); load16f(cw + 2 * DG, lane, w2); load16f(cb, lane, bb);
    float pp[16], pc[16], pn[16], ta[16], tb[16];
    const bf16_t* base = proj + (size_t)tk0 * PSTR;
    if (t0 > 0) { load16(base - PSTR + OFF_C, lane, ta); load16(base - PSTR + OFF_U, lane, tb);
#pragma unroll
        for (int e = 0; e < 16; ++e) pp[e] = ta[e] * tb[e]; }
    else {
#pragma unroll
        for (int e = 0; e < 16; ++e) pp[e] = 0.f; }
    load16(base + OFF_C, lane, ta); load16(base + OFF_U, lane, tb);
#pragma unroll
    for (int e = 0; e < 16; ++e) pc[e] = ta[e] * tb[e];
#pragma unroll 1
    for (int i = 0; i < 8; ++i) {
        const bf16_t* rp = base + (size_t)i * PSTR;
        if (t0 + i + 1 < SEQ) { load16(rp + PSTR + OFF_C, lane, ta); load16(rp + PSTR + OFF_U, lane, tb);
#pragma unroll
            for (int e = 0; e < 16; ++e) pn[e] = ta[e] * tb[e]; }
        else {
#pragma unroll
            for (int e = 0; e < 16; ++e) pn[e] = 0.f; }
        load16(rp + OFF_B, lane, ta); load16(rp + OFF_ZC, lane, tb);
        float v[16], ss = 0.f;
#pragma unroll
        for (int e = 0; e < 16; ++e) { v[e] = ta[e] * (w0[e] * pp[e] + w1[e] * pc[e] + w2[e] * pn[e] + bb[e]); ss += v[e] * v[e]; }
        const float rstd = 1.0f / sqrtf(wave_sum(ss) * (1.0f / DG) + EPS);
        float g[16]; load16f(gc, lane, g);
#pragma unroll
        for (int e = 0; e < 16; ++e) v[e] = v[e] * rstd * g[e] * silu_f(tb[e]);
        store16(ycat + (size_t)(tk0 + i) * DM, lane, v);
#pragma unroll
        for (int e = 0; e < 16; ++e) { pp[e] = pc[e]; pc[e] = pn[e]; }
    }
}

#if ATTN_NAIVE
__device__ __forceinline__ void attn_naive_item(const bf16_t* __restrict__ qkv, bf16_t* __restrict__ obuf, float* __restrict__ ssqa, int item, int tid) {
    const int bh = item >> 2, b = bh >> 4, h = bh & 15, t = (item & 3) * 512 + tid;
    const size_t tokb = (size_t)b * SEQ;
    float q[64], O[64];
    const bf16_t* qh = qkv + (size_t)bh * SEQ * HD; const bf16_t* kh = qh + (size_t)MTOK * DG; const bf16_t* vh = kh + (size_t)MTOK * DG;
    { const u32x4* qp = (const u32x4*)(qh + (size_t)t * HD);
#pragma unroll
      for (int i = 0; i < 8; ++i) { const u32x4 w = qp[i]; unpack8(w, q + 8 * i); } }
#pragma unroll
    for (int d = 0; d < 64; ++d) O[d] = 0.f;
    float M = -1e30f, Ls = 0.f;
    const float slope = exp2f(-0.5f * (float)(h + 1));
    for (int br = 0; br < 3; ++br) {
        const int R = br == 0 ? 1 : (br == 1 ? 4 : 16); const float sr = slope * (float)R;
        for (int j = -64; j <= 64; ++j) {
            const int pos = t + R * j; if (pos < 0 || pos >= SEQ) continue;
            const u32x4* kp = (const u32x4*)(kh + (size_t)pos * HD); const u32x4* vp = (const u32x4*)(vh + (size_t)pos * HD);
            float dot = 0.f;
#pragma unroll
            for (int i = 0; i < 8; ++i) { const u32x4 w = kp[i]; float kf[8]; unpack8(w, kf);
#pragma unroll
                for (int e = 0; e < 8; ++e) dot += q[8 * i + e] * kf[e]; }
            const float s = dot * 0.125f - sr * fabsf((float)j);
            const float mn = fmaxf(M, s), a = __expf(M - mn), p = __expf(s - mn); Ls = Ls * a + p; M = mn;
#pragma unroll
            for (int i = 0; i < 8; ++i) { const u32x4 w = vp[i]; float vf[8]; unpack8(w, vf);
#pragma unroll
                for (int e = 0; e < 8; ++e) O[8 * i + e] = O[8 * i + e] * a + p * vf[e]; }
        }
    }
    const float inv = 1.0f / Ls; float ss = 0.f;
    u32x4* op = (u32x4*)(obuf + (tokb + t) * DG + h * HD);
#pragma unroll
    for (int i = 0; i < 8; ++i) { float o[8];
#pragma unroll
        for (int e = 0; e < 8; ++e) { o[e] = O[8 * i + e] * inv; ss += o[e] * o[e]; }
        u32x4 w; w.x = pk(o[0], o[1]); w.y = pk(o[2], o[3]); w.z = pk(o[4], o[5]); w.w = pk(o[6], o[7]); op[i] = w; }
    ssqa[(tokb + t) * NH + h] = ss;
}
constexpr int NATT = BATCH * NH * 4;
#else
namespace att {
constexpr int KROW = 144, NROWS = 256, KBUF = NROWS * KROW, BUFB = 2 * KBUF;
static_assert(2 * BUFB <= LDS_BYTES, "attention LDS map");
constexpr int UNITS_PER_BH = 48, NUNITS = BATCH * NH * UNITS_PER_BH;
typedef short v4i16_t __attribute__((ext_vector_type(4)));
__device__ __forceinline__ v4i16_t vtr(LAS unsigned char* p) { return __builtin_amdgcn_ds_read_tr16_b64_v4i16((LAS v4i16_t*)p); }

__device__ __forceinline__ void decode_unit(int u, int& bh, int& br, int& rho, int& jb) {
    bh = u / UNITS_PER_BH; const int r = u - bh * UNITS_PER_BH;
    if (r < 16) { br = 0; rho = 0; jb = r; } else if (r < 32) { br = 1; rho = (r - 16) >> 2; jb = (r - 16) & 3; } else { br = 2; rho = r - 32; jb = 0; }
}
__device__ __forceinline__ void stage_load(const bf16_t* __restrict__ qkv, int bh, int br, int rho, int jb, int tid, u32x4 (&st)[8]) {
    const int R = 1 << (2 * br), L = SEQ >> (2 * br);
    const bf16_t* kh = qkv + (size_t)MTOK * DG + (size_t)bh * SEQ * HD + 8 * (tid & 7); const bf16_t* vh = kh + (size_t)MTOK * DG;
#pragma unroll
    for (int c = 0; c < 4; ++c) { int I = 128 * jb - 64 + (tid >> 3) + 64 * c; I = I < 0 ? 0 : (I > L - 1 ? L - 1 : I);
        const size_t off = (size_t)(rho + R * I) * HD; st[c] = *(const u32x4*)(kh + off); st[4 + c] = *(const u32x4*)(vh + off); }
}
__device__ __forceinline__ void stage_store(LAS unsigned char* buf, int tid, const u32x4 (&st)[8]) {
    LAS unsigned char* p = buf + (tid >> 3) * KROW + (tid & 7) * 16;
#pragma unroll
    for (int c = 0; c < 4; ++c) { *(LAS u32x4*)(p + 64 * c * KROW) = st[c]; *(LAS u32x4*)(p + KBUF + 64 * c * KROW) = st[4 + c]; }
}
__device__ __forceinline__ void load_q(const bf16_t* __restrict__ qkv, int bh, int br, int rho, int jb, int wave, int lane, bf16x8& q0, bf16x8& q1) {
    const int R = 1 << (2 * br);
    const bf16_t* qp = qkv + (size_t)bh * SEQ * HD + (size_t)(rho + R * (128 * jb + 16 * wave + (lane & 15))) * HD + 8 * (lane >> 4);
    q0 = *(const bf16x8*)qp; q1 = *(const bf16x8*)(qp + 32);
}

__device__ __forceinline__ void unit_compute(LAS unsigned char* buf, const bf16x8 qf0, const bf16x8 qf1, int I0, int L, float sl2, int wave, int lane,
                                             bf16_t* __restrict__ po  , float* __restrict__ plse) {
    const int q = lane & 15, quad = lane >> 4;
    LAS unsigned char* kb = buf + (16 * wave + q) * KROW + quad * 16;
    f32x4 s[5][2];
#pragma unroll
    for (int tau = 0; tau < 5; ++tau)
#pragma unroll
        for (int hf = 0; hf < (tau == 4 ? 1 : 2); ++hf) { const int lo = I0 - 64 + 32 * tau + 16 * hf;
            f32x4 acc = (f32x4){0.f, 0.f, 0.f, 0.f};
            if (lo + 15 >= 0 && lo < L) {
                const bf16x8 k0 = *(const LAS bf16x8*)(kb + (32 * tau + 16 * hf) * KROW), k1 = *(const LAS bf16x8*)(kb + (32 * tau + 16 * hf) * KROW + 64);
                acc = __builtin_amdgcn_mfma_f32_16x16x32_bf16(k0, qf0, acc, 0, 0, 0);
                acc = __builtin_amdgcn_mfma_f32_16x16x32_bf16(k1, qf1, acc, 0, 0, 0); }
            s[tau][hf] = acc; }
    const float relb = (float)(4 * quad - 64 - q); const int ikb = I0 - 64 + 4 * quad; const float c1 = 0.125f * LOG2E;
    float m = -1e30f;
#pragma unroll
    for (int tau = 0; tau < 5; ++tau)
#pragma unroll
        for (int hf = 0; hf < (tau == 4 ? 1 : 2); ++hf)
#pragma unroll
            for (int i = 0; i < 4; ++i) { const int kc = 32 * tau + 16 * hf + i; const float rel = relb + (float)kc, arel = fabsf(rel); const int Ik = ikb + kc;
                const bool ok = (arel <= 64.f) && ((unsigned)Ik < (unsigned)L);
                float v = s[tau][hf][i] * c1 - sl2 * arel; v = ok ? v : -1e30f; s[tau][hf][i] = v; m = fmaxf(m, v); }
    m = fmaxf(m, __shfl_xor(m, 16)); m = fmaxf(m, __shfl_xor(m, 32));
    float lsum = 0.f; bf16x8 pb[5];
#pragma unroll
    for (int tau = 0; tau < 5; ++tau) { float p[8];
#pragma unroll
        for (int i = 0; i < 4; ++i) { p[i] = __builtin_amdgcn_exp2f(s[tau][0][i] - m); p[4 + i] = tau == 4 ? 0.f : __builtin_amdgcn_exp2f(s[tau][1][i] - m); }
        lsum += ((p[0] + p[1]) + (p[2] + p[3])) + ((p[4] + p[5]) + (p[6] + p[7]));
        u32x4 w; w.x = pk(p[0], p[1]); w.y = pk(p[2], p[3]); w.z = pk(p[4], p[5]); w.w = pk(p[6], p[7]); pb[tau] = __builtin_bit_cast(bf16x8, w); }
    f32x4 o[4];
#pragma unroll
    for (int c = 0; c < 4; ++c) o[c] = (f32x4){0.f, 0.f, 0.f, 0.f};
    LAS unsigned char* vrd = buf + KBUF + (16 * wave + 4 * quad + (q >> 2)) * KROW + 8 * (q & 3);
#pragma unroll
    for (int tau = 0; tau < 5; ++tau) { const int lo = I0 - 64 + 32 * tau;
        if (lo + 31 >= 0 && lo < L) {
#pragma unroll
            for (int c = 0; c < 4; ++c) { const v4i16_t vl = vtr(vrd + 32 * tau * KROW + 32 * c), vh = tau == 4 ? (v4i16_t){0, 0, 0, 0} : vtr(vrd + (32 * tau + 16) * KROW + 32 * c);
                const bf16x8 a = (bf16x8){vl[0], vl[1], vl[2], vl[3], vh[0], vh[1], vh[2], vh[3]};
                o[c] = __builtin_amdgcn_mfma_f32_16x16x32_bf16(a, pb[tau], o[c], 0, 0, 0); } } }
    float l = lsum + __shfl_xor(lsum, 16); l += __shfl_xor(l, 32);
    const float inv = 1.0f / l;
#pragma unroll
    for (int c = 0; c < 4; ++c) { u32x2 w; w.x = pk(o[c][0] * inv, o[c][1] * inv); w.y = pk(o[c][2] * inv, o[c][3] * inv); *(u32x2*)(po + 16 * c + 4 * quad) = w; }
    if (quad == 0) *plse = m + __builtin_amdgcn_logf(l);
}
}

__device__ __forceinline__ void attn_units(const bf16_t* __restrict__ qkv, bf16_t* __restrict__ parto, float* __restrict__ lse, LAS unsigned char* lds, int ubeg, int uend, int tid, int wave, int lane) {
    using namespace att;
    if (ubeg >= uend) return;
    u32x4 st[8]; bf16x8 qc0, qc1, qn0, qn1;
    int bh, br, rho, jb;
    decode_unit(ubeg, bh, br, rho, jb);
    stage_load(qkv, bh, br, rho, jb, tid, st); load_q(qkv, bh, br, rho, jb, wave, lane, qc0, qc1);
    stage_store(lds, tid, st);
    __syncthreads();
#pragma unroll 1
    for (int u = ubeg; u < uend; ++u) {
        LAS unsigned char* buf = lds + ((u - ubeg) & 1) * BUFB;
        const bool more = (u + 1 < uend);
        if (more) { int bh2, br2, rho2, jb2; decode_unit(u + 1, bh2, br2, rho2, jb2); stage_load(qkv, bh2, br2, rho2, jb2, tid, st); load_q(qkv, bh2, br2, rho2, jb2, wave, lane, qn0, qn1); }
        decode_unit(u, bh, br, rho, jb);
        { const int R = 1 << (2 * br), L = SEQ >> (2 * br), I0 = 128 * jb + 16 * wave, b = bh >> 4, h = bh & 15;
          const float sl2 = exp2f(-0.5f * (float)(h + 1)) * LOG2E * (float)R;
          const size_t tok = (size_t)b * SEQ + rho + R * (I0 + (lane & 15));
          unit_compute(buf, qc0, qc1, I0, L, sl2, wave, lane, parto + ((size_t)br * MTOK + tok) * DG + h * HD, lse + ((size_t)br * MTOK + tok) * NH + h); }
        if (more) { stage_store(lds + (((u - ubeg) & 1) ^ 1) * BUFB, tid, st); qc0 = qn0; qc1 = qn1; }
        __syncthreads();
    }
}

#endif

struct Args { const float* in[12]; float* out; unsigned char* ws; int ph_lo, ph_hi; };
__global__ void __launch_bounds__(NWAVES * 64, 2) mk_fwd(Args args) {
    extern __shared__ __attribute__((aligned(16))) unsigned char lds_raw[];
    LAS unsigned char* lds = (LAS unsigned char*)lds_raw;
    const int tid = threadIdx.x, lane = tid & 63, wave = __builtin_amdgcn_readfirstlane(tid >> 6);
    const int G = gridDim.x, bx = blockIdx.x, vcu = (G % 8 == 0) ? (bx % 8) * (G / 8) + bx / 8 : bx;
    const float *x = args.in[0], *cvec = args.in[1], *w_ada = args.in[2], *b_ada = args.in[3], *g_pre = args.in[4], *w_in = args.in[5], *conv_w = args.in[6], *conv_b = args.in[7],
                *g_conv = args.in[8], *g_attn = args.in[9], *w_out = args.in[10], *g_post = args.in[11];
    unsigned char* ws = args.ws;
    float* modp = (float*)(ws + WS_MODP); float* gate = (float*)(ws + WS_GATE); float* lse = (float*)(ws + WS_LSE); float* ssqy = (float*)(ws + WS_SSQY);
    bf16_t* woutT = (bf16_t*)(ws + WS_WOUTT); bf16_t* winT = (bf16_t*)(ws + WS_WINT); bf16_t* parto = (bf16_t*)(ws + WS_PARTO); bf16_t* hbuf = (bf16_t*)(ws + WS_H);
    bf16_t* ycat = (bf16_t*)(ws + WS_YCAT); bf16_t* proj = (bf16_t*)(ws + WS_PROJ); bf16_t* ybuf = (bf16_t*)(ws + WS_Y); bf16_t* qkv = (bf16_t*)(ws + WS_QKV);
    const int lo = args.ph_lo, hi = args.ph_hi;
    const int gw = bx * NWAVES + wave, NGW = G * NWAVES;
#define IN(k) (lo <= (k) && (k) < hi)
    volatile LAS unsigned* bst = (volatile LAS unsigned*)(lds + LDS_PHASE);
    if (tid < 2) bst[tid] = 0u;
    __syncthreads();
    XcdBarrier xbar; xbar.bar = (unsigned*)ws; xbar.x = 0; xbar.st = bst;
    if (hi - lo > 1) xbar = xcd_barrier_post((unsigned*)ws, bst);
#define SEAM(k) do { if (IN(k) && IN((k) + 1)) { if ((k) == 0) cg::this_grid().sync(); else xcd_barrier(xbar); } } while (0)

    if (IN(0)) {
        LAS float* scr = (LAS float*)(lds + wave * 16384);
        constexpr int I_MOD = KSPLIT * 48, I_IN = (DM / 64) * (NPROJ / 32), I_OUT = (DM / 64) * (DM / 32);
        for (int it = gw; it < I_MOD + I_IN + I_OUT; it += NGW) {
            if (it < I_MOD) p0_mod_item(cvec, w_ada, modp, scr, it, lane);
            else if (it < I_MOD + I_IN) p0_transpose_item(w_in, DM, NPROJ, winT, scr, it - I_MOD, lane);
            else p0_transpose_item(w_out, DM, DM, woutT, scr, it - I_MOD - I_IN, lane);
        }
    }
    SEAM(0);
    if (IN(1)) p1_rows(x, b_ada, g_pre, modp, gate, hbuf, lds, bx, G, tid, wave, lane);
    SEAM(1);
    if (IN(2)) {
        pg8::Gemm g{hbuf, winT, MTOK, NPROJ, DM}; pg8::StaticOrder S; S.init(MTOK, NPROJ, G, bx);
        pg8::EpiProj E{proj, qkv};
        pg8::gemm_phase<pg8::EpiProj, pg8::StaticOrder, PG8_ALIGN, PG8_SP2>(lds, g, S, E);
    }
    SEAM(2);
    if (IN(3)) {
#if ATTN_NAIVE
        for (int it = vcu; it < NATT; it += G) attn_naive_item(qkv, parto, lse, it, tid);
#else
        attn_units(qkv, parto, lse, lds, (int)(((long)vcu * att::NUNITS) / G), (int)(((long)(vcu + 1) * att::NUNITS) / G), tid, wave, lane);
#endif
        for (int it = vcu; it < MTOK / 64; it += G) conv_unit(proj, conv_w, conv_b, g_conv, ycat, it, wave, lane);
    }
    SEAM(3);
    if (IN(4)) {
        for (int row = gw; row < MTOK; row += NGW) {
            float ov[16], zv[16], g[16], ss = 0.f;
            load16(proj + (size_t)row * PSTR + OFF_ZA5, lane, zv); load16f(g_attn, lane, g);
#pragma unroll
            for (int j = 0; j < 2; ++j) {
                const int hd = 8 * j + (lane >> 3); const size_t li = (size_t)row * NH + hd, oi = (size_t)row * DG + 512 * j + 8 * lane;
                const float l0 = lse[li], l1 = lse[(size_t)MTOK * NH + li], l2 = lse[2 * (size_t)MTOK * NH + li];
                const u32x4 a0 = *(const u32x4*)(parto + oi), a1 = *(const u32x4*)(parto + (size_t)MTOK * DG + oi), a2 = *(const u32x4*)(parto + 2 * (size_t)MTOK * DG + oi);
                const float mx = fmaxf(l0, fmaxf(l1, l2)); float w0 = __builtin_amdgcn_exp2f(l0 - mx), w1 = __builtin_amdgcn_exp2f(l1 - mx), w2 = __builtin_amdgcn_exp2f(l2 - mx);
                const float iw = 1.0f / (w0 + w1 + w2); w0 *= iw; w1 *= iw; w2 *= iw;
                float f0[8], f1[8], f2[8]; unpack8(a0, f0); unpack8(a1, f1); unpack8(a2, f2);
#pragma unroll
                for (int e = 0; e < 8; ++e) { const float o = w0 * f0[e] + w1 * f1[e] + w2 * f2[e]; ov[8 * j + e] = o; ss += o * o; } }
            const float rstd = 1.0f / sqrtf(wave_sum(ss) * (1.0f / DG) + EPS);
#pragma unroll
            for (int e = 0; e < 16; ++e) ov[e] = ov[e] * rstd * g[e] * silu_f(zv[e]);
            store16(ycat + (size_t)row * DM + DG, lane, ov);
        }
    }
    SEAM(4);
    if (IN(5)) {
        pg8::Gemm g{ycat, woutT, MTOK, DM, DM}; pg8::StaticOrder S; S.init(MTOK, DM, G, bx);
        pg8::EpiY E{ybuf, DM, ssqy};
        pg8::gemm_phase<pg8::EpiY, pg8::StaticOrder, PG8_ALIGN, PG8_SP2>(lds, g, S, E);
    }
    SEAM(5);
    if (IN(6)) {
        for (int row = gw; row < MTOK; row += NGW) {
            const int b = row >> 11;
            const float sv = lane < 32 ? ssqy[(size_t)row * 32 + lane] : 0.f;
            const float rstd = 1.0f / sqrtf(wave_sum(sv) * (1.0f / DM) + EPS);
#pragma unroll
            for (int j = 0; j < 4; ++j) { const int c = 512 * j + 8 * lane; const size_t off = (size_t)row * DM + c;
                const u32x4 yw = *(const u32x4*)(ybuf + off); float yv[8]; unpack8(yw, yv);
                const f32x4 x0 = *(const f32x4*)(x + off), x1 = *(const f32x4*)(x + off + 4), g0 = *(const f32x4*)(gate + b * DM + c), g1 = *(const f32x4*)(gate + b * DM + c + 4),
                            p0 = *(const f32x4*)(g_post + c), p1 = *(const f32x4*)(g_post + c + 4);
                f32x4 o0, o1;
#pragma unroll
                for (int e = 0; e < 4; ++e) { o0[e] = x0[e] + g0[e] * p0[e] * (yv[e] * rstd); o1[e] = x1[e] + g1[e] * p1[e] * (yv[4 + e] * rstd); }
                *(f32x4*)(args.out + off) = o0; *(f32x4*)(args.out + off + 4) = o1; }
        }
    }
#undef IN
#undef SEAM
}

extern "C" void kernel_launch(void* const* d_in, const int* in_sizes, int n_in, void* d_out, int out_size, void* d_ws, size_t ws_size, hipStream_t stream) {
    static int grid = 0;
    if (grid == 0) {
        if (n_in != 12 || in_sizes[0] != MTOK * DM || out_size != MTOK * DM || ws_size < WS_END) { fprintf(stderr, "kernel_launch: unexpected problem (n_in %d, in0 %d, out %d, ws %zu); nothing launched\n", n_in, n_in > 0 ? in_sizes[0] : -1, out_size, ws_size); grid = -1; return; }
        int dev = 0, cus = 0, per_cu = 0;
        if (hipGetDevice(&dev) != hipSuccess || hipDeviceGetAttribute(&cus, hipDeviceAttributeMultiprocessorCount, dev) != hipSuccess) { grid = -1; return; }
        if (hipFuncSetAttribute((const void*)mk_fwd, hipFuncAttributeMaxDynamicSharedMemorySize, LDS_BYTES) != hipSuccess) { fprintf(stderr, "kernel_launch: hipFuncSetAttribute failed\n"); grid = -1; return; }
        if (hipOccupancyMaxActiveBlocksPerMultiprocessor(&per_cu, (const void*)mk_fwd, NWAVES * 64, LDS_BYTES) != hipSuccess || per_cu < 1) { fprintf(stderr, "kernel_launch: occupancy query says %d blocks per CU\n", per_cu); (void)hipGetLastError(); grid = -1; return; }
        grid = cus * per_cu;
    }
    if (grid < 0) return;
    if (hipMemsetAsync(d_ws, 0, 16384, stream) != hipSuccess) { fprintf(stderr, "kernel_launch: memset of the barrier words failed\n"); return; }
    Args a{};
    for (int i = 0; i < 12; ++i) a.in[i] = (const float*)d_in[i];
    a.out = (float*)d_out; a.ws = (unsigned char*)d_ws;
#if MK_N_LAUNCHES == 1
    a.ph_lo = 0; a.ph_hi = NPHASE;
    void* kargs[] = {&a};
    hipError_t e = hipLaunchCooperativeKernel((const void*)mk_fwd, dim3(grid), dim3(NWAVES * 64), kargs, LDS_BYTES, stream);
    if (e != hipSuccess) fprintf(stderr, "kernel_launch: cooperative launch failed: %s (grid %d)\n", hipGetErrorString(e), grid);
#ifdef PROBE_PHASE
    a.ph_lo = PROBE_PHASE; a.ph_hi = PROBE_PHASE + 1; hipLaunchKernelGGL(mk_fwd, dim3(grid), dim3(NWAVES * 64), LDS_BYTES, stream, a);
#endif
#else
    for (int p = 0; p < NPHASE; ++p) { a.ph_lo = p; a.ph_hi = p + 1; hipLaunchKernelGGL(mk_fwd, dim3(grid), dim3(NWAVES * 64), LDS_BYTES, stream, a); }
#endif
}
```

```cpp
#include <hip/hip_runtime.h>
#include <hip/hip_cooperative_groups.h>
#include <cstdio>
#include <cstdint>
namespace cg = cooperative_groups;
namespace pg8 {
#define PG8_LAS __attribute__((address_space(3)))
typedef unsigned short bf16_t;
typedef short bf16x8 __attribute__((ext_vector_type(8)));
typedef float f32x4 __attribute__((ext_vector_type(4)));
typedef unsigned u32x4 __attribute__((ext_vector_type(4)));
constexpr int BM = 256, BK = 64, HALF = 128, HTB = HALF * BK * 2  , STAGE_BYTES = 8 * HTB, NXCD = 8, WGM = 8;

__host__ __device__ __forceinline__ int lds_byte(int r, int c) { const int st = (r >> 4) * 2 + (c >> 5), rr = r & 15, cc = c & 31, ob = rr * 64 + cc * 2; return st * 1024 + (ob ^ (((ob >> 9) & 1) << 5)); }
__host__ __device__ __forceinline__ void stage_rc(int b, int& R, int& C) { const int st = b / 1024, sb = b % 1024, swz = sb ^ (((sb >> 9) & 1) << 5); R = (st >> 1) * 16 + swz / 64; C = (st & 1) * 32 + (swz % 64) / 2; }
__host__ __device__ __forceinline__ int perm32(int rho) { const int n = rho >> 4, i = rho & 15; return 8 * (i >> 2) + 4 * n + (i & 3); }

struct Unit { int pm, pn; };
struct Gemm { const bf16_t* A; const bf16_t* Bt; int M, N, K; };

struct StaticOrder {
    int nM, nN, nwg, G, c;
    __host__ __device__ void init(int M, int N, int G_, int c_) { nM = M / BM; nN = N / BM; nwg = nM * nN; G = G_; c = c_; }
    __host__ __device__ bool next(int i, Unit& u) const {
        const long L = (long)i * G + c; if (L >= nwg) return false;
        int wgid = (int)L; { const int q = nwg / NXCD, r = nwg % NXCD, xcd = wgid % NXCD, off = wgid / NXCD; wgid = (xcd < r ? xcd * (q + 1) : r * (q + 1) + (xcd - r) * q) + off; }
        const int nig = WGM * nN, gid = wgid / nig, fm = gid * WGM, gsz = (nM - fm) < WGM ? (nM - fm) : WGM;
        u.pm = fm + ((wgid % nig) % gsz); u.pn = (wgid % nig) / gsz; return true;
    }
    __device__ __forceinline__ void a_ready(const Unit&) const {}
    __device__ __forceinline__ void done(const Unit&) const {}
};

__device__ __forceinline__ unsigned cvt_pk_bf16(float lo, float hi) { unsigned r; asm volatile("v_cvt_pk_bf16_f32 %0, %1, %2" : "=v"(r) : "v"(lo), "v"(hi)); return r; }
typedef float f32x2 __attribute__((ext_vector_type(2)));
__device__ __forceinline__ f32x2 gelu_pk(f32x2 v) {
    const f32x2 av = __builtin_elementwise_abs(v), d = av * 0.2316418882f + 1.0f;
    f32x2 t; t.x = __builtin_amdgcn_rcpf(d.x); t.y = __builtin_amdgcn_rcpf(d.y);
    f32x2 q = t * 0.5307027145f + (-0.7265760135f); q = q * t + 0.7107068705f; q = q * t + (-0.142248368f); q = q * t + 0.127414796f; q = q * t;
    const f32x2 s = (v * v) * (-0.72134752044f);
    f32x2 e; e.x = __builtin_amdgcn_exp2f(s.x); e.y = __builtin_amdgcn_exp2f(s.y);
    const f32x2 m = v * (q * e), r = v - m;
    f32x2 o; o.x = v.x < 0.f ? m.x : r.x; o.y = v.y < 0.f ? m.y : r.y; return o;
}

template <int ACT  > struct EpiBf16 {
    static constexpr bool PERM = true, AFTER_DRAIN = false; static_assert(ACT == 0 || ACT == 1, "EpiBf16: ACT is 0 (none) or 1 (gelu_pk)");
    bf16_t* O; int ldc; const float* bias; int split_cols; size_t split_stride; float scale0;
    __device__ __forceinline__ void operator()(const f32x4 (&acc)[2][2][4][2], const Unit& u, int wr, int wc, int fr, int fq) const {
        const int row0 = u.pm * BM + wr * 64 + fr; int colt = u.pn * BM; bf16_t* base = O;
        float sc = 1.f; if (split_cols) { const int t = colt / split_cols; base += (size_t)t * split_stride; colt -= t * split_cols; if (t == 0) sc = scale0; }
        const int col0 = colt + wc * 32 + 8 * fq, bcol0 = u.pn * BM + wc * 32 + 8 * fq;
        f32x4 bv[2][2];
#pragma unroll
        for (int bj = 0; bj < 2; ++bj)
#pragma unroll
            for (int n = 0; n < 2; ++n) bv[bj][n] = bias ? *(const f32x4*)(bias + bcol0 + bj * HALF + 4 * n) : (f32x4){0.f, 0.f, 0.f, 0.f};
#pragma unroll
        for (int ai = 0; ai < 2; ++ai)
#pragma unroll
            for (int m = 0; m < 4; ++m) { bf16_t* rowp = base + (size_t)(row0 + ai * HALF + m * 16) * ldc + col0;
#pragma unroll
                for (int bj = 0; bj < 2; ++bj) { f32x4 v0 = acc[ai][bj][m][0] + bv[bj][0], v1 = acc[ai][bj][m][1] + bv[bj][1];
                    if (ACT == 1) { f32x2 a = gelu_pk((f32x2){v0[0], v0[1]}), b = gelu_pk((f32x2){v0[2], v0[3]}), c = gelu_pk((f32x2){v1[0], v1[1]}), d = gelu_pk((f32x2){v1[2], v1[3]});
                        v0 = (f32x4){a.x, a.y, b.x, b.y}; v1 = (f32x4){c.x, c.y, d.x, d.y}; }
                    v0 = v0 * sc; v1 = v1 * sc; u32x4 w; w.x = cvt_pk_bf16(v0[0], v0[1]); w.y = cvt_pk_bf16(v0[2], v0[3]); w.z = cvt_pk_bf16(v1[0], v1[1]); w.w = cvt_pk_bf16(v1[2], v1[3]);
                    *(u32x4*)(rowp + bj * HALF) = w; } }
    }
};
struct EpiY {
    static constexpr bool PERM = true, AFTER_DRAIN = false;
    bf16_t* Y; int ldc; float* ssq;
    __device__ __forceinline__ void operator()(const f32x4 (&acc)[2][2][4][2], const Unit& u, int wr, int wc, int fr, int fq) const {
        const int row0 = u.pm * BM + wr * 64 + fr; const int col0 = u.pn * BM + wc * 32 + 8 * fq;
#pragma unroll
        for (int ai = 0; ai < 2; ++ai)
#pragma unroll
            for (int m = 0; m < 4; ++m) { const int row = row0 + ai * HALF + m * 16; bf16_t* rowp = Y + (size_t)row * ldc + col0; float ss = 0.f;
#pragma unroll
                for (int bj = 0; bj < 2; ++bj) { const f32x4 v0 = acc[ai][bj][m][0], v1 = acc[ai][bj][m][1];
                    ss += (v0[0] * v0[0] + v0[1] * v0[1]) + (v0[2] * v0[2] + v0[3] * v0[3]) + (v1[0] * v1[0] + v1[1] * v1[1]) + (v1[2] * v1[2] + v1[3] * v1[3]);
                    u32x4 w; w.x = cvt_pk_bf16(v0[0], v0[1]); w.y = cvt_pk_bf16(v0[2], v0[3]); w.z = cvt_pk_bf16(v1[0], v1[1]); w.w = cvt_pk_bf16(v1[2], v1[3]);
                    *(u32x4*)(rowp + bj * HALF) = w; }
                ss += __shfl_xor(ss, 16); ss += __shfl_xor(ss, 32);
                if (fq == 0) ssq[(size_t)row * 32 + u.pn * 4 + wc] = ss; }
    }
};
struct EpiProj {
    static constexpr bool PERM = true, AFTER_DRAIN = false;
    bf16_t* P; bf16_t* QKV;
    __device__ __forceinline__ void operator()(const f32x4 (&acc)[2][2][4][2], const Unit& u, int wr, int wc, int fr, int fq) const {
        const int row0 = u.pm * BM + wr * 64 + fr, colt = u.pn * BM;
        if (colt < 4096 || colt >= 7168) {
            const int col0 = (colt < 4096 ? colt : colt - 3072) + wc * 32 + 8 * fq;
#pragma unroll
            for (int ai = 0; ai < 2; ++ai)
#pragma unroll
                for (int m = 0; m < 4; ++m) { bf16_t* rowp = P + (size_t)(row0 + ai * HALF + m * 16) * 5120 + col0;
#pragma unroll
                    for (int bj = 0; bj < 2; ++bj) { const f32x4 v0 = acc[ai][bj][m][0], v1 = acc[ai][bj][m][1];
                        u32x4 w; w.x = cvt_pk_bf16(v0[0], v0[1]); w.y = cvt_pk_bf16(v0[2], v0[3]); w.z = cvt_pk_bf16(v1[0], v1[1]); w.w = cvt_pk_bf16(v1[2], v1[3]);
                        *(u32x4*)(rowp + bj * HALF) = w; } }
        } else {
            const int which = (colt - 4096) >> 10, cin = ((colt - 4096) & 1023) + wc * 32 + 8 * fq;
            bf16_t* base = QKV + (size_t)which * (16384u * 1024u);
#pragma unroll
            for (int ai = 0; ai < 2; ++ai)
#pragma unroll
                for (int m = 0; m < 4; ++m) { const int row = row0 + ai * HALF + m * 16, b = row >> 11, t = row & 2047;
#pragma unroll
                    for (int bj = 0; bj < 2; ++bj) { const int c = cin + bj * HALF, head = c >> 6, d = c & 63;
                        const f32x4 v0 = acc[ai][bj][m][0], v1 = acc[ai][bj][m][1];
                        u32x4 w; w.x = cvt_pk_bf16(v0[0], v0[1]); w.y = cvt_pk_bf16(v0[2], v0[3]); w.z = cvt_pk_bf16(v1[0], v1[1]); w.w = cvt_pk_bf16(v1[2], v1[3]);
                        *(u32x4*)(base + ((size_t)((b * 16 + head) * 2048 + t)) * 64 + d) = w; } }
        }
    }
};
template <class Epi, class Sched, bool ALIGN_EPI = false, bool SP2 = false>
__device__ __forceinline__ void gemm_phase(PG8_LAS unsigned char* lds, const Gemm g, const Sched& S, const Epi& E) {
    const int tid = threadIdx.x, wid = __builtin_amdgcn_readfirstlane(tid >> 6), lane = tid & 63, wr = wid >> 2, wc = wid & 3, fr = lane & 15, fq = lane >> 4;
    const int K = g.K, nt = K / BK;
    unsigned voffA[2], voffB[2];
#pragma unroll
    for (int i = 0; i < 2; ++i) { int R, C; stage_rc(tid * 16 + i * 8192, R, C); const int Rb = Epi::PERM ? ((R & ~31) + perm32(R & 31)) : R;
        voffA[i] = (unsigned)(R * K + C) * 2u; voffB[i] = (unsigned)(Rb * K + C) * 2u; }
    const size_t kstep = (size_t)(BK * 2);
    const size_t hstep = (size_t)HALF * K * 2;
    const size_t tstep = 2 * hstep;
    const unsigned ldsw = (unsigned)wid * 1024u;
    const int aoff = lds_byte(wr * 64 + fr, fq * 8), boff = lds_byte(wc * 32 + fr, fq * 8);
#define PG8_SA(b, h) (((b) * 2 + (h)) * HTB)
#define PG8_SB(b, h) ((4 + (b) * 2 + (h)) * HTB)
#define PG8_STAGE(bufoff, gbase, voff) do { _Pragma("unroll") for (int _i = 0; _i < 2; ++_i) \
        __builtin_amdgcn_global_load_lds((const unsigned*)((const char*)(gbase) + (voff)[_i]), (PG8_LAS unsigned*)(lds + (bufoff) + ldsw + _i * 8192), 16, 0, 0); } while (0)
#define PG8_LDA(dst, b, h) do { _Pragma("unroll") for (int m = 0; m < 4; ++m) _Pragma("unroll") for (int k = 0; k < 2; ++k) dst[m][k] = *(const PG8_LAS bf16x8*)(lds + PG8_SA(b, h) + aoff + m * 2048 + k * 1024); } while (0)
#define PG8_LDB(dst, b, h) do { _Pragma("unroll") for (int n = 0; n < 2; ++n) _Pragma("unroll") for (int k = 0; k < 2; ++k) dst[n][k] = *(const PG8_LAS bf16x8*)(lds + PG8_SB(b, h) + boff + n * 2048 + k * 1024); } while (0)
#define PG8_MMA(ai, bj, At, Bt) do { __builtin_amdgcn_s_setprio(1); _Pragma("unroll") for (int m = 0; m < 4; ++m) _Pragma("unroll") for (int n = 0; n < 2; ++n) _Pragma("unroll") for (int k = 0; k < 2; ++k) \
        acc[ai][bj][m][n] = __builtin_amdgcn_mfma_f32_16x16x32_bf16(Bt[n][k], At[m][k], acc[ai][bj][m][n], 0, 0, 0); __builtin_amdgcn_s_setprio(0); } while (0)
#define PG8_WAIT_V(n) asm volatile("s_waitcnt vmcnt(" #n ")" ::: "memory")
#define PG8_WAIT_L(n) asm volatile("s_waitcnt lgkmcnt(" #n ")" ::: "memory")
#define PG8_BAR __builtin_amdgcn_s_barrier()
#define PG8_SCHED __builtin_amdgcn_sched_barrier(0)
    Unit cur, nxt; int ui = 0;
    if (!S.next(0, cur)) return;
    f32x4 acc[2][2][4][2];
#pragma unroll
    for (int a = 0; a < 2; ++a)
#pragma unroll
        for (int b = 0; b < 2; ++b)
#pragma unroll
            for (int m = 0; m < 4; ++m)
#pragma unroll
                for (int n = 0; n < 2; ++n) acc[a][b][m][n] = (f32x4){0.f, 0.f, 0.f, 0.f};
    bf16x8 At[4][2], B0[2][2], B1[2][2];
    const char* cA = (const char*)g.A + (size_t)cur.pm * tstep; const char* cB = (const char*)g.Bt + (size_t)cur.pn * tstep;
    S.a_ready(cur);
    if constexpr (SP2) {
        PG8_STAGE(PG8_SB(0, 0), cB, voffB); PG8_STAGE(PG8_SB(0, 1), cB + hstep, voffB); PG8_STAGE(PG8_SA(0, 0), cA, voffA); PG8_STAGE(PG8_SA(0, 1), cA + hstep, voffA);
        if (wr == 1) PG8_BAR;
        PG8_WAIT_V(2); PG8_BAR;
        PG8_STAGE(PG8_SB(1, 0), cB + kstep, voffB); PG8_STAGE(PG8_SA(1, 0), cA + kstep, voffA); PG8_STAGE(PG8_SB(1, 1), cB + hstep + kstep, voffB);
        PG8_WAIT_V(6); PG8_BAR;
    } else {
        PG8_STAGE(PG8_SB(0, 0), cB, voffB); PG8_STAGE(PG8_SA(0, 0), cA, voffA); PG8_STAGE(PG8_SB(0, 1), cB + hstep, voffB); PG8_STAGE(PG8_SA(0, 1), cA + hstep, voffA);
        if (wr == 1) PG8_BAR;
        PG8_WAIT_V(4); PG8_BAR;
        PG8_STAGE(PG8_SB(1, 0), cB + kstep, voffB); PG8_STAGE(PG8_SA(1, 0), cA + kstep, voffA); PG8_STAGE(PG8_SB(1, 1), cB + hstep + kstep, voffB);
        PG8_WAIT_V(6); PG8_BAR;
    }
    for (;;) {
        const bool has_next = S.next(ui + 1, nxt);
        const char* nA = has_next ? (const char*)g.A + (size_t)nxt.pm * tstep : cA; const char* nB = has_next ? (const char*)g.Bt + (size_t)nxt.pn * tstep : cB;
        for (int t = 0; t < nt; t += 2) {
            const bool last = (t == nt - 2);
            const char* a1 = cA + (size_t)(t + 1) * kstep;
            const char* a2 = last ? nA : cA + (size_t)(t + 2) * kstep; const char* b2 = last ? nB : cB + (size_t)(t + 2) * kstep;
            const char* a3 = a2 + kstep; const char* b3 = b2 + kstep;
            if (last && has_next) S.a_ready(nxt);
            if constexpr (SP2) {
            PG8_LDB(B0, 0, 0); PG8_LDB(B1, 0, 1); PG8_SCHED; PG8_LDA(At, 0, 0); PG8_STAGE(PG8_SA(1, 1), a1 + hstep, voffA);
            PG8_WAIT_V(8); PG8_WAIT_L(0); PG8_BAR; PG8_MMA(0, 0, At, B0); PG8_MMA(0, 1, At, B1); PG8_BAR; PG8_SCHED;
            PG8_LDA(At, 0, 1); PG8_STAGE(PG8_SB(0, 0), b2, voffB); PG8_STAGE(PG8_SB(0, 1), b2 + hstep, voffB); PG8_STAGE(PG8_SA(0, 0), a2, voffA);
            PG8_WAIT_V(8); PG8_WAIT_L(0); PG8_BAR; PG8_MMA(1, 0, At, B0); PG8_MMA(1, 1, At, B1); PG8_BAR; PG8_SCHED;
            PG8_LDB(B0, 1, 0); PG8_LDB(B1, 1, 1); PG8_SCHED; PG8_LDA(At, 1, 0); PG8_STAGE(PG8_SA(0, 1), a2 + hstep, voffA);
            PG8_WAIT_V(8); PG8_WAIT_L(0); PG8_BAR; PG8_MMA(0, 0, At, B0); PG8_MMA(0, 1, At, B1); PG8_BAR; PG8_SCHED;
            PG8_LDA(At, 1, 1); PG8_STAGE(PG8_SB(1, 0), b3, voffB); PG8_STAGE(PG8_SB(1, 1), b3 + hstep, voffB); PG8_STAGE(PG8_SA(1, 0), a3, voffA);
            PG8_WAIT_V(8); PG8_WAIT_L(0); PG8_BAR; PG8_MMA(1, 0, At, B0); PG8_MMA(1, 1, At, B1); PG8_BAR; PG8_SCHED;
            } else {
            PG8_LDB(B0, 0, 0); PG8_SCHED; PG8_LDA(At, 0, 0); PG8_STAGE(PG8_SA(1, 1), a1 + hstep, voffA);
            PG8_WAIT_L(8); PG8_BAR; PG8_WAIT_L(0); PG8_MMA(0, 0, At, B0); PG8_BAR; PG8_SCHED;
            PG8_LDB(B1, 0, 1); PG8_STAGE(PG8_SB(0, 0), b2, voffB);
            PG8_BAR; PG8_WAIT_L(0); PG8_MMA(0, 1, At, B1); PG8_BAR;
            PG8_LDA(At, 0, 1); PG8_STAGE(PG8_SA(0, 0), a2, voffA);
            PG8_BAR; PG8_WAIT_L(0); PG8_MMA(1, 0, At, B0); PG8_BAR; PG8_SCHED;
            PG8_STAGE(PG8_SB(0, 1), b2 + hstep, voffB);
            PG8_WAIT_V(6); PG8_BAR; PG8_MMA(1, 1, At, B1); PG8_BAR;
            PG8_LDB(B0, 1, 0); PG8_SCHED; PG8_LDA(At, 1, 0); PG8_STAGE(PG8_SA(0, 1), a2 + hstep, voffA);
            PG8_WAIT_L(8); PG8_BAR; PG8_WAIT_L(0); PG8_MMA(0, 0, At, B0); PG8_BAR; PG8_SCHED;
            PG8_LDB(B1, 1, 1); PG8_STAGE(PG8_SB(1, 0), b3, voffB);
            PG8_BAR; PG8_WAIT_L(0); PG8_MMA(0, 1, At, B1); PG8_BAR;
            PG8_LDA(At, 1, 1); PG8_STAGE(PG8_SA(1, 0), a3, voffA);
            PG8_BAR; PG8_WAIT_L(0); PG8_MMA(1, 0, At, B0); PG8_BAR; PG8_SCHED;
            PG8_STAGE(PG8_SB(1, 1), b3 + hstep, voffB);
            PG8_WAIT_V(6); PG8_BAR; PG8_MMA(1, 1, At, B1); PG8_BAR;
            }
        }
        if constexpr (ALIGN_EPI) { if (wr == 0) PG8_BAR; }
        if constexpr (!Epi::AFTER_DRAIN) { E(acc, cur, wr, wc, fr, fq); S.done(cur); }
        if (!has_next) break;
#pragma unroll
        for (int a = 0; a < 2; ++a)
#pragma unroll
            for (int b = 0; b < 2; ++b)
#pragma unroll
                for (int m = 0; m < 4; ++m)
#pragma unroll
                    for (int n = 0; n < 2; ++n) acc[a][b][m][n] = (f32x4){0.f, 0.f, 0.f, 0.f};
        cur = nxt; cA = nA; cB = nB; ++ui;
        if constexpr (ALIGN_EPI) { if (wr == 1) PG8_BAR; }
    }
    PG8_WAIT_V(0);
    if constexpr (!ALIGN_EPI) { if (wr == 0) PG8_BAR; }
    PG8_BAR;
    if constexpr (Epi::AFTER_DRAIN) { E.fused(acc, cur, wr, wc, fr, fq, lds, wid, lane); S.done(cur); }
#undef PG8_SA
#undef PG8_SB
#undef PG8_STAGE
#undef PG8_LDA
#undef PG8_LDB
#undef PG8_MMA
#undef PG8_WAIT_V
#undef PG8_WAIT_L
#undef PG8_BAR
#undef PG8_SCHED
}
}

#ifndef PG8_SP2
#define PG8_SP2 true
#endif
#ifndef PG8_ALIGN
#define PG8_ALIGN true
#endif
#ifndef MK_N_LAUNCHES
#define MK_N_LAUNCHES 1
#endif
#ifndef ATTN_NAIVE
#define ATTN_NAIVE 0
#endif

using pg8::bf16_t; using pg8::bf16x8; using pg8::f32x4; using pg8::u32x4;
typedef unsigned u32x2 __attribute__((ext_vector_type(2)));
typedef float f32x2 __attribute__((ext_vector_type(2)));
#define LAS __attribute__((address_space(3)))
constexpr int BATCH = 8, SEQ = 2048, DM = 2048, MTOK = BATCH * SEQ, NPROJ = 8192, DG = 1024, NH = 16, HD = 64, NMOD = 3 * DM;
constexpr int OFF_U = 0, OFF_B = 1024, OFF_C = 2048, OFF_ZC = 3072, OFF_Q = 4096, OFF_K = 5120, OFF_V = 6144, OFF_ZA = 7168;
constexpr float EPS = 1e-6f, LOG2E = 1.4426950408889634f;
constexpr int KSPLIT = 16, NWAVES = 8, NPHASE = 7;
constexpr size_t MiB = 1u << 20;
constexpr size_t WS_MODP = 1 * MiB, WS_GATE = 4 * MiB, WS_SSQY = 6 * MiB, WS_WOUTT = 8 * MiB, WS_WINT = 16 * MiB,
                 WS_H = 80 * MiB, WS_YCAT = WS_H  , WS_PROJ = 144 * MiB  , WS_Y = WS_PROJ  ,
                 WS_QKV = 304 * MiB  , WS_PARTO = 400 * MiB  , WS_LSE = 496 * MiB  , WS_END = 499 * MiB;
constexpr int PSTR = 5120, OFF_ZA5 = 4096;
constexpr int LDS_PHASE = 147456, LDS_BYTES = LDS_PHASE + 256;

#define LDS_WAIT() asm volatile("s_waitcnt lgkmcnt(0)" ::: "memory")
__device__ __forceinline__ float bf_lo(unsigned u) { return __uint_as_float(u << 16); }
__device__ __forceinline__ float bf_hi(unsigned u) { return __uint_as_float(u & 0xffff0000u); }
__device__ __forceinline__ unsigned pk(float lo, float hi) { return pg8::cvt_pk_bf16(lo, hi); }
__device__ __forceinline__ float silu_f(float v) { return v * __builtin_amdgcn_rcpf(1.f + __builtin_amdgcn_exp2f(-v * LOG2E)); }
__device__ __forceinline__ float wave_sum(float v) {
#pragma unroll
    for (int o = 1; o < 64; o <<= 1) v += __shfl_xor(v, o);
    return v;
}
__device__ __forceinline__ void unpack8(const u32x4 w, float* f) { f[0] = bf_lo(w.x); f[1] = bf_hi(w.x); f[2] = bf_lo(w.y); f[3] = bf_hi(w.y); f[4] = bf_lo(w.z); f[5] = bf_hi(w.z); f[6] = bf_lo(w.w); f[7] = bf_hi(w.w); }
__device__ __forceinline__ void load16(const bf16_t* rowp, int lane, float (&f)[16]) {
    const u32x4 a = *(const u32x4*)(rowp + 8 * lane), b = *(const u32x4*)(rowp + 512 + 8 * lane); unpack8(a, f); unpack8(b, f + 8);
}
__device__ __forceinline__ void load16f(const float* p, int lane, float (&f)[16]) {
#pragma unroll
    for (int j = 0; j < 2; ++j) { const f32x4 a = *(const f32x4*)(p + 512 * j + 8 * lane), b = *(const f32x4*)(p + 512 * j + 8 * lane + 4);
        f[8 * j + 0] = a[0]; f[8 * j + 1] = a[1]; f[8 * j + 2] = a[2]; f[8 * j + 3] = a[3]; f[8 * j + 4] = b[0]; f[8 * j + 5] = b[1]; f[8 * j + 6] = b[2]; f[8 * j + 7] = b[3]; }
}
__device__ __forceinline__ void store16(bf16_t* rowp, int lane, const float (&y)[16]) {
#pragma unroll
    for (int j = 0; j < 2; ++j) { u32x4 w; w.x = pk(y[8 * j + 0], y[8 * j + 1]); w.y = pk(y[8 * j + 2], y[8 * j + 3]); w.z = pk(y[8 * j + 4], y[8 * j + 5]); w.w = pk(y[8 * j + 6], y[8 * j + 7]);
        *(u32x4*)(rowp + 512 * j + 8 * lane) = w; }
}


typedef unsigned v4u __attribute__((ext_vector_type(4)));
#define XB_TMO      128
#define XB_XCNT(j)  (256  + 64 * (j))
#define XB_XSUB(j)  (1280 + 64 * (j))
#define XB_XGEN(j)  (2304 + 64 * (j))
#define XB_TOP      3328
#define XB_TOPGEN   3392
#define XCD_BAR_WORDS 3456
#define XB_SPIN_CAP (1u << 18)

__device__ __forceinline__ unsigned xb_ld(unsigned* p)              { return __hip_atomic_load(p, __ATOMIC_RELAXED, __HIP_MEMORY_SCOPE_AGENT); }
__device__ __forceinline__ unsigned xb_add(unsigned* p, unsigned v) { return __hip_atomic_fetch_add(p, v, __ATOMIC_RELAXED, __HIP_MEMORY_SCOPE_AGENT); }
__device__ __forceinline__ unsigned xb_xcc_id() { return (unsigned)__builtin_amdgcn_s_getreg((3 << 11) | 20) & 0xFu; }
#define XB_SPIN(cond, bar) do { unsigned _sp = 0; while (cond) { __builtin_amdgcn_s_sleep(1); \
    if ((++_sp & 255u) == 0u) { if (xb_ld(&(bar)[XB_TMO])) break; if (_sp > XB_SPIN_CAP) { atomicAdd(&(bar)[XB_TMO], 1u); break; } } } } while (0)

struct XcdBarrier {
    unsigned* bar; unsigned x;
    volatile LAS unsigned* st;
};

__device__ __forceinline__ XcdBarrier xcd_barrier_post(unsigned* bar, volatile LAS unsigned* st) {
    XcdBarrier b; b.bar = bar; b.x = xb_xcc_id(); b.st = st;
    if (threadIdx.x == 0) (void)xb_add(&bar[XB_XCNT(b.x)], 1u);
    return b;
}
__device__ __forceinline__ void xcd_barrier_complete(unsigned* bar, unsigned x, unsigned& nloc, unsigned& nx) {
    const unsigned G = gridDim.x * gridDim.y * gridDim.z;
    unsigned sum, cnt, mine, sp = 0u;
    for (;;) {
        sum = 0u; cnt = 0u; mine = 0u;
#pragma unroll
        for (unsigned j = 0; j < 16; ++j) { const unsigned c = xb_ld(&bar[XB_XCNT(j)]); sum += c; cnt += (c > 0u) ? 1u : 0u; mine = (j == x) ? c : mine; }
        if (sum == G) break;
        __builtin_amdgcn_s_sleep(1);
        if ((++sp & 255u) == 0u) { if (xb_ld(&bar[XB_TMO])) break; if (sp > XB_SPIN_CAP) { atomicAdd(&bar[XB_TMO], 1u); break; } }
    }
    nloc = mine > 0u ? mine : 1u; nx = cnt > 0u ? cnt : 1u;
}

__device__ __forceinline__ void xcd_barrier(const XcdBarrier& b) {
    asm volatile("s_waitcnt vmcnt(0)" ::: "memory");
    __syncthreads();
    if (threadIdx.x == 0) {
        unsigned* bar = b.bar;
        __builtin_amdgcn_s_waitcnt(0);
        unsigned nloc = b.st[0], nx = b.st[1];
        if (nloc == 0u) { xcd_barrier_complete(bar, b.x, nloc, nx); b.st[0] = nloc; b.st[1] = nx; }
        const unsigned old = xb_add(&bar[XB_XSUB(b.x)], 1u);
        const unsigned gen = old / nloc;
        if (old + 1u == (gen + 1u) * nloc) {
            __builtin_amdgcn_fence(__ATOMIC_RELEASE, "agent");
            asm volatile("s_waitcnt vmcnt(0)" ::: "memory");
            const unsigned og = xb_add(&bar[XB_TOP], 1u);
            const unsigned tg = og / nx;
            if (og + 1u == (tg + 1u) * nx) xb_add(&bar[XB_TOPGEN], 1u);
            else XB_SPIN(xb_ld(&bar[XB_TOPGEN]) == tg, bar);
            __builtin_amdgcn_fence(__ATOMIC_ACQUIRE, "agent");
            xb_add(&bar[XB_XGEN(b.x)], 1u);
            asm volatile("s_waitcnt vmcnt(0)" ::: "memory");
        } else {
            XB_SPIN(xb_ld(&bar[XB_XGEN(b.x)]) == gen, bar);
            __builtin_amdgcn_fence(__ATOMIC_ACQUIRE, "agent");
            asm volatile("s_waitcnt vmcnt(0)" ::: "memory");
        }
    }
    __syncthreads();
}

__device__ __forceinline__ void p0_transpose_item(const float* __restrict__ W, int K, int N, bf16_t* __restrict__ WT, LAS float* scr, int item, int lane) {
    const int nblk = N / 32, kb = item / nblk, nb = item % nblk, k0 = 64 * kb, n0 = 32 * nb;
#pragma unroll 8
    for (int i = 0; i < 32; ++i) { const int kk = 2 * i + (lane >> 5); scr[kk * 33 + (lane & 31)] = W[(size_t)(k0 + kk) * N + n0 + (lane & 31)]; }
    LDS_WAIT();
    const int c = lane & 7;
#pragma unroll
    for (int j = 0; j < 4; ++j) { const int n = (lane >> 3) + 8 * j; const LAS float* s = scr + (8 * c) * 33 + n;
        u32x4 o; o.x = pk(s[0 * 33], s[1 * 33]); o.y = pk(s[2 * 33], s[3 * 33]); o.z = pk(s[4 * 33], s[5 * 33]); o.w = pk(s[6 * 33], s[7 * 33]);
        *(u32x4*)(WT + (size_t)(n0 + n) * K + k0 + 8 * c) = o; }
    LDS_WAIT();
}
__device__ __forceinline__ void p0_mod_item(const float* __restrict__ cvec, const float* __restrict__ wada, float* __restrict__ modp, LAS float* scr, int item, int lane) {
    const int kc = item / 48, nc = item % 48, k0 = kc * 128, n0 = nc * 128;
#pragma unroll
    for (int i = 0; i < 16; ++i) { const int idx = i * 64 + lane, b = idx >> 7, kk = idx & 127; scr[kk * 8 + b] = silu_f(cvec[b * DM + k0 + kk]); }
    LDS_WAIT();
    float acc[8][2];
#pragma unroll
    for (int b = 0; b < 8; ++b) { acc[b][0] = 0.f; acc[b][1] = 0.f; }
    const float* wp = wada + (size_t)k0 * NMOD + n0 + 2 * lane;
#pragma unroll 8
    for (int kk = 0; kk < 128; ++kk) {
        const f32x2 w = *(const f32x2*)(wp + (size_t)kk * NMOD);
        const f32x4 s0 = *(const LAS f32x4*)(scr + kk * 8), s1 = *(const LAS f32x4*)(scr + kk * 8 + 4);
        acc[0][0] += s0[0] * w[0]; acc[0][1] += s0[0] * w[1]; acc[1][0] += s0[1] * w[0]; acc[1][1] += s0[1] * w[1];
        acc[2][0] += s0[2] * w[0]; acc[2][1] += s0[2] * w[1]; acc[3][0] += s0[3] * w[0]; acc[3][1] += s0[3] * w[1];
        acc[4][0] += s1[0] * w[0]; acc[4][1] += s1[0] * w[1]; acc[5][0] += s1[1] * w[0]; acc[5][1] += s1[1] * w[1];
        acc[6][0] += s1[2] * w[0]; acc[6][1] += s1[2] * w[1]; acc[7][0] += s1[3] * w[0]; acc[7][1] += s1[3] * w[1];
    }
#pragma unroll
    for (int b = 0; b < 8; ++b) *(f32x2*)(modp + ((size_t)kc * 8 + b) * NMOD + n0 + 2 * lane) = (f32x2){acc[b][0], acc[b][1]};
    LDS_WAIT();
}

__device__ __forceinline__ void p1_rows(const float* __restrict__ x, const float* __restrict__ b_ada, const float* __restrict__ g_pre, const float* __restrict__ modp,
                                        float* __restrict__ gate, bf16_t* __restrict__ hbuf, LAS unsigned char* lds, int bx, int G, int tid, int wave, int lane) {
    LAS float* Ac = (LAS float*)lds; LAS float* Sc = Ac + DM;
    for (int chunk = bx; chunk < MTOK / 64; chunk += G) {
        const int b = chunk >> 5;
        __syncthreads();
        { const int d = tid * 4;
          f32x4 sh = *(const f32x4*)(b_ada + d), sc = *(const f32x4*)(b_ada + DM + d);
#pragma unroll 4
          for (int kc = 0; kc < KSPLIT; ++kc) { const float* p = modp + ((size_t)kc * 8 + b) * NMOD + d; sh += *(const f32x4*)p; sc += *(const f32x4*)(p + DM); }
          const f32x4 g = *(const f32x4*)(g_pre + d);
          *(LAS f32x4*)(Ac + d) = g * (sc + 1.0f); *(LAS f32x4*)(Sc + d) = sh;
          if ((chunk & 31) == 0) { f32x4 gt = *(const f32x4*)(b_ada + 2 * DM + d);
#pragma unroll 4
              for (int kc = 0; kc < KSPLIT; ++kc) gt += *(const f32x4*)(modp + ((size_t)kc * 8 + b) * NMOD + 2 * DM + d);
              *(f32x4*)(gate + b * DM + d) = gt; } }
        __syncthreads();
        for (int i = 0; i < 8; ++i) {
            const int row = chunk * 64 + wave * 8 + i;
            const f32x4* xr = (const f32x4*)(x + (size_t)row * DM) + lane;
            f32x4 v[8]; float s = 0.f;
#pragma unroll
            for (int j = 0; j < 8; ++j) { v[j] = xr[64 * j]; s += (v[j][0] * v[j][0] + v[j][1] * v[j][1]) + (v[j][2] * v[j][2] + v[j][3] * v[j][3]); }
            const float rstd = 1.0f / sqrtf(wave_sum(s) * (1.0f / DM) + EPS);
            u32x2* o8 = (u32x2*)(hbuf + (size_t)row * DM) + lane;
#pragma unroll
            for (int j = 0; j < 8; ++j) { const int d = 4 * lane + 256 * j; const f32x4 a = *(const LAS f32x4*)(Ac + d), sft = *(const LAS f32x4*)(Sc + d);
                const f32x4 o = v[j] * rstd * a + sft; u32x2 w; w.x = pk(o[0], o[1]); w.y = pk(o[2], o[3]); o8[64 * j] = w; }
        }
    }
}

__device__ __forceinline__ void conv_unit(const bf16_t* __restrict__ proj, const float* __restrict__ cw, const float* __restrict__ cb, const float* __restrict__ gc,
                                          bf16_t* __restrict__ ycat, int unit, int wave, int lane) {
    const int tk0 = unit * 64 + wave * 8, t0 = tk0 & (SEQ - 1);
    float w0[16], w1[16], w2[16], bb[16];
    load16f(cw, lane, w0); load16f(cw + DG, lane, w1); load16f(cw + 2 * DG, lane, w2); load16f(cb, lane, bb);
    float pp[16], pc[16], pn[16], ta[16], tb[16];
    const bf16_t* base = proj + (size_t)tk0 * PSTR;
    if (t0 > 0) { load16(base - PSTR + OFF_C, lane, ta); load16(base - PSTR + OFF_U, lane, tb);
#pragma unroll
        for (int e = 0; e < 16; ++e) pp[e] = ta[e] * tb[e]; }
    else {
#pragma unroll
        for (int e = 0; e < 16; ++e) pp[e] = 0.f; }
    load16(base + OFF_C, lane, ta); load16(base + OFF_U, lane, tb);
#pragma unroll
    for (int e = 0; e < 16; ++e) pc[e] = ta[e] * tb[e];
    u32x4 rc[2], ru[2], rb[2], rz[2], nc[2], nu[2], nb[2], nz[2];
    const u32x4 zero4 = (u32x4){0u, 0u, 0u, 0u};
#define LD2(dst, p) do { dst[0] = *(const u32x4*)((p) + 8 * lane); dst[1] = *(const u32x4*)((p) + 512 + 8 * lane); } while (0)
    if (t0 + 1 < SEQ) { LD2(rc, base + PSTR + OFF_C); LD2(ru, base + PSTR + OFF_U); } else { rc[0] = rc[1] = ru[0] = ru[1] = zero4; }
    LD2(rb, base + OFF_B); LD2(rz, base + OFF_ZC);
    float g[16]; load16f(gc, lane, g);
#pragma unroll 1
    for (int i = 0; i < 8; ++i) {
        const bf16_t* rp = base + (size_t)i * PSTR;
        if (i + 1 < 8) { LD2(nb, rp + PSTR + OFF_B); LD2(nz, rp + PSTR + OFF_ZC);
            if (t0 + i + 2 < SEQ) { LD2(nc, rp + 2 * PSTR + OFF_C); LD2(nu, rp + 2 * PSTR + OFF_U); } else { nc[0] = nc[1] = nu[0] = nu[1] = zero4; } }
        unpack8(rc[0], ta); unpack8(rc[1], ta + 8); unpack8(ru[0], tb); unpack8(ru[1], tb + 8);
#pragma unroll
        for (int e = 0; e < 16; ++e) pn[e] = ta[e] * tb[e];
        unpack8(rb[0], ta); unpack8(rb[1], ta + 8); unpack8(rz[0], tb); unpack8(rz[1], tb + 8);
        float v[16], ss = 0.f;
#pragma unroll
        for (int e = 0; e < 16; ++e) { v[e] = ta[e] * (w0[e] * pp[e] + w1[e] * pc[e] + w2[e] * pn[e] + bb[e]); ss += v[e] * v[e]; }
        const float rstd = 1.0f / sqrtf(wave_sum(ss) * (1.0f / DG) + EPS);
#pragma unroll
        for (int e = 0; e < 16; ++e) v[e] = v[e] * rstd * g[e] * silu_f(tb[e]);
        store16(ycat + (size_t)(tk0 + i) * DM, lane, v);
#pragma unroll
        for (int e = 0; e < 16; ++e) { pp[e] = pc[e]; pc[e] = pn[e]; }
        rc[0] = nc[0]; rc[1] = nc[1]; ru[0] = nu[0]; ru[1] = nu[1]; rb[0] = nb[0]; rb[1] = nb[1]; rz[0] = nz[0]; rz[1] = nz[1];
    }
#undef LD2
}

#if ATTN_NAIVE
__device__ __forceinline__ void attn_naive_item(const bf16_t* __restrict__ qkv, bf16_t* __restrict__ obuf, float* __restrict__ ssqa, int item, int tid) {
    const int bh = item >> 2, b = bh >> 4, h = bh & 15, t = (item & 3) * 512 + tid;
    const size_t tokb = (size_t)b * SEQ;
    float q[64], O[64];
    const bf16_t* qh = qkv + (size_t)bh * SEQ * HD; const bf16_t* kh = qh + (size_t)MTOK * DG; const bf16_t* vh = kh + (size_t)MTOK * DG;
    { const u32x4* qp = (const u32x4*)(qh + (size_t)t * HD);
#pragma unroll
      for (int i = 0; i < 8; ++i) { const u32x4 w = qp[i]; unpack8(w, q + 8 * i); } }
#pragma unroll
    for (int d = 0; d < 64; ++d) O[d] = 0.f;
    float M = -1e30f, Ls = 0.f;
    const float slope = exp2f(-0.5f * (float)(h + 1));
    for (int br = 0; br < 3; ++br) {
        const int R = br == 0 ? 1 : (br == 1 ? 4 : 16); const float sr = slope * (float)R;
        for (int j = -64; j <= 64; ++j) {
            const int pos = t + R * j; if (pos < 0 || pos >= SEQ) continue;
            const u32x4* kp = (const u32x4*)(kh + (size_t)pos * HD); const u32x4* vp = (const u32x4*)(vh + (size_t)pos * HD);
            float dot = 0.f;
#pragma unroll
            for (int i = 0; i < 8; ++i) { const u32x4 w = kp[i]; float kf[8]; unpack8(w, kf);
#pragma unroll
                for (int e = 0; e < 8; ++e) dot += q[8 * i + e] * kf[e]; }
            const float s = dot * 0.125f - sr * fabsf((float)j);
            const float mn = fmaxf(M, s), a = __expf(M - mn), p = __expf(s - mn); Ls = Ls * a + p; M = mn;
#pragma unroll
            for (int i = 0; i < 8; ++i) { const u32x4 w = vp[i]; float vf[8]; unpack8(w, vf);
#pragma unroll
                for (int e = 0; e < 8; ++e) O[8 * i + e] = O[8 * i + e] * a + p * vf[e]; }
        }
    }
    const float inv = 1.0f / Ls; float ss = 0.f;
    u32x4* op = (u32x4*)(obuf + (tokb + t) * DG + h * HD);
#pragma unroll
    for (int i = 0; i < 8; ++i) { float o[8];
#pragma unroll
        for (int e = 0; e < 8; ++e) { o[e] = O[8 * i + e] * inv; ss += o[e] * o[e]; }
        u32x4 w; w.x = pk(o[0], o[1]); w.y = pk(o[2], o[3]); w.z = pk(o[4], o[5]); w.w = pk(o[6], o[7]); op[i] = w; }
    ssqa[(tokb + t) * NH + h] = ss;
}
constexpr int NATT = BATCH * NH * 4;
#else
namespace att {
constexpr int KROW = 144, NROWS = 256, KBUF = NROWS * KROW, BUFB = 2 * KBUF;
static_assert(2 * BUFB <= LDS_BYTES, "attention LDS map");
constexpr int UNITS_PER_BH = 48, NUNITS = BATCH * NH * UNITS_PER_BH;
typedef short v4i16_t __attribute__((ext_vector_type(4)));
__device__ __forceinline__ v4i16_t vtr(LAS unsigned char* p) { return __builtin_amdgcn_ds_read_tr16_b64_v4i16((LAS v4i16_t*)p); }

__device__ __forceinline__ void decode_unit(int u, int& bh, int& br, int& rho, int& jb) {
    bh = u / UNITS_PER_BH; const int r = u - bh * UNITS_PER_BH;
    if (r < 16) { br = 0; rho = 0; jb = r; } else if (r < 32) { br = 1; rho = (r - 16) >> 2; jb = (r - 16) & 3; } else { br = 2; rho = r - 32; jb = 0; }
}
__device__ __forceinline__ void stage_load(const bf16_t* __restrict__ qkv, int bh, int br, int rho, int jb, int tid, u32x4 (&st)[8]) {
    const int R = 1 << (2 * br), L = SEQ >> (2 * br);
    const bf16_t* kh = qkv + (size_t)MTOK * DG + (size_t)bh * SEQ * HD + 8 * (tid & 7); const bf16_t* vh = kh + (size_t)MTOK * DG;
#pragma unroll
    for (int c = 0; c < 4; ++c) { int I = 128 * jb - 64 + (tid >> 3) + 64 * c; I = I < 0 ? 0 : (I > L - 1 ? L - 1 : I);
        const size_t off = (size_t)(rho + R * I) * HD; st[c] = *(const u32x4*)(kh + off); st[4 + c] = *(const u32x4*)(vh + off); }
}
__device__ __forceinline__ void stage_store(LAS unsigned char* buf, int tid, const u32x4 (&st)[8]) {
    LAS unsigned char* p = buf + (tid >> 3) * KROW + (tid & 7) * 16;
#pragma unroll
    for (int c = 0; c < 4; ++c) { *(LAS u32x4*)(p + 64 * c * KROW) = st[c]; *(LAS u32x4*)(p + KBUF + 64 * c * KROW) = st[4 + c]; }
}
__device__ __forceinline__ void load_q(const bf16_t* __restrict__ qkv, int bh, int br, int rho, int jb, int wave, int lane, bf16x8& q0, bf16x8& q1) {
    const int R = 1 << (2 * br);
    const bf16_t* qp = qkv + (size_t)bh * SEQ * HD + (size_t)(rho + R * (128 * jb + 16 * wave + (lane & 15))) * HD + 8 * (lane >> 4);
    q0 = *(const bf16x8*)qp; q1 = *(const bf16x8*)(qp + 32);
}

__device__ __forceinline__ void unit_compute(LAS unsigned char* buf, const bf16x8 qf0, const bf16x8 qf1, int I0, int L, const float (&T)[36], int wave, int lane,
                                             bf16_t* __restrict__ po  , float* __restrict__ plse) {
    const int q = lane & 15, quad = lane >> 4;
    LAS unsigned char* kb = buf + (16 * wave + q) * KROW + quad * 16;
    f32x4 s[5][2];
#pragma unroll
    for (int tau = 0; tau < 5; ++tau)
#pragma unroll
        for (int hf = 0; hf < (tau == 4 ? 1 : 2); ++hf) { const int lo = I0 - 64 + 32 * tau + 16 * hf;
            f32x4 acc = (f32x4){0.f, 0.f, 0.f, 0.f};
            if (lo + 15 >= 0 && lo < L) {
                const bf16x8 k0 = *(const LAS bf16x8*)(kb + (32 * tau + 16 * hf) * KROW), k1 = *(const LAS bf16x8*)(kb + (32 * tau + 16 * hf) * KROW + 64);
                acc = __builtin_amdgcn_mfma_f32_16x16x32_bf16(k0, qf0, acc, 0, 0, 0);
                acc = __builtin_amdgcn_mfma_f32_16x16x32_bf16(k1, qf1, acc, 0, 0, 0); }
            s[tau][hf] = acc; }
    const float c1 = 0.125f * LOG2E;
#pragma unroll
    for (int tau = 0; tau < 5; ++tau)
#pragma unroll
        for (int hf = 0; hf < (tau == 4 ? 1 : 2); ++hf)
#pragma unroll
            for (int i = 0; i < 4; ++i) s[tau][hf][i] = s[tau][hf][i] * c1 + T[8 * tau + 4 * hf + i];
    if (I0 < 64 || I0 + 80 > L) {
        const int ikb = I0 - 64 + 4 * quad;
#pragma unroll
        for (int tau = 0; tau < 5; ++tau)
#pragma unroll
            for (int hf = 0; hf < (tau == 4 ? 1 : 2); ++hf)
#pragma unroll
                for (int i = 0; i < 4; ++i) { const int Ik = ikb + 32 * tau + 16 * hf + i; s[tau][hf][i] = ((unsigned)Ik < (unsigned)L) ? s[tau][hf][i] : -1e30f; }
    }
    float m = -1e30f;
#pragma unroll
    for (int tau = 0; tau < 5; ++tau)
#pragma unroll
        for (int hf = 0; hf < (tau == 4 ? 1 : 2); ++hf)
#pragma unroll
            for (int i = 0; i < 4; ++i) m = fmaxf(m, s[tau][hf][i]);
    m = fmaxf(m, __shfl_xor(m, 16)); m = fmaxf(m, __shfl_xor(m, 32));
    float lsum = 0.f; bf16x8 pb[5];
#pragma unroll
    for (int tau = 0; tau < 5; ++tau) { float p[8];
#pragma unroll
        for (int i = 0; i < 4; ++i) { p[i] = __builtin_amdgcn_exp2f(s[tau][0][i] - m); p[4 + i] = tau == 4 ? 0.f : __builtin_amdgcn_exp2f(s[tau][1][i] - m); }
        lsum += ((p[0] + p[1]) + (p[2] + p[3])) + ((p[4] + p[5]) + (p[6] + p[7]));
        u32x4 w; w.x = pk(p[0], p[1]); w.y = pk(p[2], p[3]); w.z = pk(p[4], p[5]); w.w = pk(p[6], p[7]); pb[tau] = __builtin_bit_cast(bf16x8, w); }
    f32x4 o[4];
#pragma unroll
    for (int c = 0; c < 4; ++c) o[c] = (f32x4){0.f, 0.f, 0.f, 0.f};
    LAS unsigned char* vrd = buf + KBUF + (16 * wave + 4 * quad + (q >> 2)) * KROW + 8 * (q & 3);
#pragma unroll
    for (int tau = 0; tau < 5; ++tau) { const int lo = I0 - 64 + 32 * tau;
        if (lo + 31 >= 0 && lo < L) {
#pragma unroll
            for (int c = 0; c < 4; ++c) { const v4i16_t vl = vtr(vrd + 32 * tau * KROW + 32 * c), vh = tau == 4 ? (v4i16_t){0, 0, 0, 0} : vtr(vrd + (32 * tau + 16) * KROW + 32 * c);
                const bf16x8 a = (bf16x8){vl[0], vl[1], vl[2], vl[3], vh[0], vh[1], vh[2], vh[3]};
                o[c] = __builtin_amdgcn_mfma_f32_16x16x32_bf16(a, pb[tau], o[c], 0, 0, 0); } } }
    float l = lsum + __shfl_xor(lsum, 16); l += __shfl_xor(l, 32);
    const float inv = 1.0f / l;
#pragma unroll
    for (int c = 0; c < 4; ++c) { u32x2 w; w.x = pk(o[c][0] * inv, o[c][1] * inv); w.y = pk(o[c][2] * inv, o[c][3] * inv); *(u32x2*)(po + 16 * c + 4 * quad) = w; }
    if (quad == 0) *plse = m + __builtin_amdgcn_logf(l);
}
}

__device__ __forceinline__ void attn_units(const bf16_t* __restrict__ qkv, bf16_t* __restrict__ parto, float* __restrict__ lse, LAS unsigned char* lds, int ubeg, int uend, int tid, int wave, int lane) {
    using namespace att;
    if (ubeg >= uend) return;
    u32x4 st[8]; bf16x8 qc0, qc1, qn0, qn1;
    int bh, br, rho, jb;
    float T[36]; int tkey = -1;
    decode_unit(ubeg, bh, br, rho, jb);
    stage_load(qkv, bh, br, rho, jb, tid, st); load_q(qkv, bh, br, rho, jb, wave, lane, qc0, qc1);
    stage_store(lds, tid, st);
    __syncthreads();
#pragma unroll 1
    for (int u = ubeg; u < uend; ++u) {
        LAS unsigned char* buf = lds + ((u - ubeg) & 1) * BUFB;
        const bool more = (u + 1 < uend);
        if (more) { int bh2, br2, rho2, jb2; decode_unit(u + 1, bh2, br2, rho2, jb2); stage_load(qkv, bh2, br2, rho2, jb2, tid, st); load_q(qkv, bh2, br2, rho2, jb2, wave, lane, qn0, qn1); }
        decode_unit(u, bh, br, rho, jb);
        { const int R = 1 << (2 * br), L = SEQ >> (2 * br), I0 = 128 * jb + 16 * wave, b = bh >> 4, h = bh & 15;
          if (bh * 4 + br != tkey) {
              tkey = bh * 4 + br; const float sl2 = exp2f(-0.5f * (float)(h + 1)) * LOG2E * (float)R; const float relb = (float)(4 * (lane >> 4) - 64 - (lane & 15));
#pragma unroll
              for (int k = 0; k < 36; ++k) { const float arel = fabsf(relb + (float)(32 * (k >> 3) + 16 * ((k >> 2) & 1) + (k & 3))); T[k] = arel <= 64.f ? -sl2 * arel : -1e30f; } }
          const size_t tok = (size_t)b * SEQ + rho + R * (I0 + (lane & 15));
          unit_compute(buf, qc0, qc1, I0, L, T, wave, lane, parto + ((size_t)br * MTOK + tok) * DG + h * HD, lse + ((size_t)br * MTOK + tok) * NH + h); }
        if (more) { stage_store(lds + (((u - ubeg) & 1) ^ 1) * BUFB, tid, st); qc0 = qn0; qc1 = qn1; }
        __syncthreads();
    }
}

#endif

struct Args { const float* in[12]; float* out; unsigned char* ws; int ph_lo, ph_hi; };
__global__ void __launch_bounds__(NWAVES * 64, 2) mk_fwd(Args args) {
    extern __shared__ __attribute__((aligned(16))) unsigned char lds_raw[];
    LAS unsigned char* lds = (LAS unsigned char*)lds_raw;
    const int tid = threadIdx.x, lane = tid & 63, wave = __builtin_amdgcn_readfirstlane(tid >> 6);
    const int G = gridDim.x, bx = blockIdx.x, vcu = (G % 8 == 0) ? (bx % 8) * (G / 8) + bx / 8 : bx;
    const float *x = args.in[0], *cvec = args.in[1], *w_ada = args.in[2], *b_ada = args.in[3], *g_pre = args.in[4], *w_in = args.in[5], *conv_w = args.in[6], *conv_b = args.in[7],
                *g_conv = args.in[8], *g_attn = args.in[9], *w_out = args.in[10], *g_post = args.in[11];
    unsigned char* ws = args.ws;
    float* modp = (float*)(ws + WS_MODP); float* gate = (float*)(ws + WS_GATE); float* lse = (float*)(ws + WS_LSE); float* ssqy = (float*)(ws + WS_SSQY);
    bf16_t* woutT = (bf16_t*)(ws + WS_WOUTT); bf16_t* winT = (bf16_t*)(ws + WS_WINT); bf16_t* parto = (bf16_t*)(ws + WS_PARTO); bf16_t* hbuf = (bf16_t*)(ws + WS_H);
    bf16_t* ycat = (bf16_t*)(ws + WS_YCAT); bf16_t* proj = (bf16_t*)(ws + WS_PROJ); bf16_t* ybuf = (bf16_t*)(ws + WS_Y); bf16_t* qkv = (bf16_t*)(ws + WS_QKV);
    const int lo = args.ph_lo, hi = args.ph_hi;
    const int gw = bx * NWAVES + wave, NGW = G * NWAVES;
#define IN(k) (lo <= (k) && (k) < hi)
    volatile LAS unsigned* bst = (volatile LAS unsigned*)(lds + LDS_PHASE);
    if (tid < 2) bst[tid] = 0u;
    __syncthreads();
    XcdBarrier xbar; xbar.bar = (unsigned*)ws; xbar.x = 0; xbar.st = bst;
    if (hi - lo > 1) xbar = xcd_barrier_post((unsigned*)ws, bst);
#define SEAM(k) do { if (IN(k) && IN((k) + 1)) { if ((k) == 0) cg::this_grid().sync(); else xcd_barrier(xbar); } } while (0)

    if (IN(0)) {
        LAS float* scr = (LAS float*)(lds + wave * 16384);
        constexpr int I_MOD = KSPLIT * 48, I_IN = (DM / 64) * (NPROJ / 32), I_OUT = (DM / 64) * (DM / 32);
        for (int it = gw; it < I_MOD + I_IN + I_OUT; it += NGW) {
            if (it < I_MOD) p0_mod_item(cvec, w_ada, modp, scr, it, lane);
            else if (it < I_MOD + I_IN) p0_transpose_item(w_in, DM, NPROJ, winT, scr, it - I_MOD, lane);
            else p0_transpose_item(w_out, DM, DM, woutT, scr, it - I_MOD - I_IN, lane);
        }
    }
    SEAM(0);
    if (IN(1)) p1_rows(x, b_ada, g_pre, modp, gate, hbuf, lds, bx, G, tid, wave, lane);
    SEAM(1);
    if (IN(2)) {
        pg8::Gemm g{hbuf, winT, MTOK, NPROJ, DM}; pg8::StaticOrder S; S.init(MTOK, NPROJ, G, bx);
        pg8::EpiProj E{proj, qkv};
        pg8::gemm_phase<pg8::EpiProj, pg8::StaticOrder, PG8_ALIGN, PG8_SP2>(lds, g, S, E);
    }
    SEAM(2);
    if (IN(3)) {
#if ATTN_NAIVE
        for (int it = vcu; it < NATT; it += G) attn_naive_item(qkv, parto, lse, it, tid);
#else
        attn_units(qkv, parto, lse, lds, (int)(((long)vcu * att::NUNITS) / G), (int)(((long)(vcu + 1) * att::NUNITS) / G), tid, wave, lane);
#endif
        for (int it = vcu; it < MTOK / 64; it += G) conv_unit(proj, conv_w, conv_b, g_conv, ycat, it, wave, lane);
    }
    SEAM(3);
    if (IN(4)) {
        for (int row = gw; row < MTOK; row += NGW) {
            float ov[16], zv[16], g[16], ss = 0.f;
            load16(proj + (size_t)row * PSTR + OFF_ZA5, lane, zv); load16f(g_attn, lane, g);
#pragma unroll
            for (int j = 0; j < 2; ++j) {
                const int hd = 8 * j + (lane >> 3); const size_t li = (size_t)row * NH + hd, oi = (size_t)row * DG + 512 * j + 8 * lane;
                const float l0 = lse[li], l1 = lse[(size_t)MTOK * NH + li], l2 = lse[2 * (size_t)MTOK * NH + li];
                const u32x4 a0 = *(const u32x4*)(parto + oi), a1 = *(const u32x4*)(parto + (size_t)MTOK * DG + oi), a2 = *(const u32x4*)(parto + 2 * (size_t)MTOK * DG + oi);
                const float mx = fmaxf(l0, fmaxf(l1, l2)); float w0 = __builtin_amdgcn_exp2f(l0 - mx), w1 = __builtin_amdgcn_exp2f(l1 - mx), w2 = __builtin_amdgcn_exp2f(l2 - mx);
                const float iw = 1.0f / (w0 + w1 + w2); w0 *= iw; w1 *= iw; w2 *= iw;
                float f0[8], f1[8], f2[8]; unpack8(a0, f0); unpack8(a1, f1); unpack8(a2, f2);
#pragma unroll
                for (int e = 0; e < 8; ++e) { const float o = w0 * f0[e] + w1 * f1[e] + w2 * f2[e]; ov[8 * j + e] = o; ss += o * o; } }
            const float rstd = 1.0f / sqrtf(wave_sum(ss) * (1.0f / DG) + EPS);
#pragma unroll
            for (int e = 0; e < 16; ++e) ov[e] = ov[e] * rstd * g[e] * silu_f(zv[e]);
            store16(ycat + (size_t)row * DM + DG, lane, ov);
        }
    }
    SEAM(4);
    if (IN(5)) {
        pg8::Gemm g{ycat, woutT, MTOK, DM, DM}; pg8::StaticOrder S; S.init(MTOK, DM, G, bx);
        pg8::EpiY E{ybuf, DM, ssqy};
        pg8::gemm_phase<pg8::EpiY, pg8::StaticOrder, PG8_ALIGN, PG8_SP2>(lds, g, S, E);
    }
    SEAM(5);
    if (IN(6)) {
        f32x4 gp[4][2];
#pragma unroll
        for (int j = 0; j < 4; ++j) { gp[j][0] = *(const f32x4*)(g_post + 512 * j + 8 * lane); gp[j][1] = *(const f32x4*)(g_post + 512 * j + 8 * lane + 4); }
#pragma unroll 1
        for (int r0 = gw; r0 < MTOK; r0 += 2 * NGW) {
            u32x4 yw[2][4]; f32x4 xv[2][4][2], gt[2][4][2]; float sv[2];
#pragma unroll
            for (int rr = 0; rr < 2; ++rr) { const int row = r0 + rr * NGW, b = row >> 11; sv[rr] = lane < 32 ? ssqy[(size_t)row * 32 + lane] : 0.f;
#pragma unroll
                for (int j = 0; j < 4; ++j) { const int c = 512 * j + 8 * lane; const size_t off = (size_t)row * DM + c;
                    yw[rr][j] = *(const u32x4*)(ybuf + off); xv[rr][j][0] = *(const f32x4*)(x + off); xv[rr][j][1] = *(const f32x4*)(x + off + 4);
                    gt[rr][j][0] = *(const f32x4*)(gate + b * DM + c); gt[rr][j][1] = *(const f32x4*)(gate + b * DM + c + 4); } }
#pragma unroll
            for (int rr = 0; rr < 2; ++rr) { const int row = r0 + rr * NGW;
                const float rstd = 1.0f / sqrtf(wave_sum(sv[rr]) * (1.0f / DM) + EPS);
#pragma unroll
                for (int j = 0; j < 4; ++j) { const size_t off = (size_t)row * DM + 512 * j + 8 * lane; float yv[8]; unpack8(yw[rr][j], yv);
                    f32x4 o0, o1;
#pragma unroll
                    for (int e = 0; e < 4; ++e) { o0[e] = xv[rr][j][0][e] + gt[rr][j][0][e] * gp[j][0][e] * (yv[e] * rstd); o1[e] = xv[rr][j][1][e] + gt[rr][j][1][e] * gp[j][1][e] * (yv[4 + e] * rstd); }
                    *(f32x4*)(args.out + off) = o0; *(f32x4*)(args.out + off + 4) = o1; } }
        }
    }
#undef IN
#undef SEAM
}

extern "C" void kernel_launch(void* const* d_in, const int* in_sizes, int n_in, void* d_out, int out_size, void* d_ws, size_t ws_size, hipStream_t stream) {
    static int grid = 0;
    if (grid == 0) {
        if (n_in != 12 || in_sizes[0] != MTOK * DM || out_size != MTOK * DM || ws_size < WS_END) { fprintf(stderr, "kernel_launch: unexpected problem (n_in %d, in0 %d, out %d, ws %zu); nothing launched\n", n_in, n_in > 0 ? in_sizes[0] : -1, out_size, ws_size); grid = -1; return; }
        int dev = 0, cus = 0, per_cu = 0;
        if (hipGetDevice(&dev) != hipSuccess || hipDeviceGetAttribute(&cus, hipDeviceAttributeMultiprocessorCount, dev) != hipSuccess) { grid = -1; return; }
        if (hipFuncSetAttribute((const void*)mk_fwd, hipFuncAttributeMaxDynamicSharedMemorySize, LDS_BYTES) != hipSuccess) { fprintf(stderr, "kernel_launch: hipFuncSetAttribute failed\n"); grid = -1; return; }
        if (hipOccupancyMaxActiveBlocksPerMultiprocessor(&per_cu, (const void*)mk_fwd, NWAVES * 64, LDS_BYTES) != hipSuccess || per_cu < 1) { fprintf(stderr, "kernel_launch: occupancy query says %d blocks per CU\n", per_cu); (void)hipGetLastError(); grid = -1; return; }
        grid = cus * per_cu;
    }
    if (grid < 0) return;
    if (hipMemsetAsync(d_ws, 0, 16384, stream) != hipSuccess) { fprintf(stderr, "kernel_launch: memset of the barrier words failed\n"); return; }
    Args a{};
    for (int i = 0; i < 12; ++i) a.in[i] = (const float*)d_in[i];
    a.out = (float*)d_out; a.ws = (unsigned char*)d_ws;
#if MK_N_LAUNCHES == 1
    a.ph_lo = 0; a.ph_hi = NPHASE;
    void* kargs[] = {&a};
    hipError_t e = hipLaunchCooperativeKernel((const void*)mk_fwd, dim3(grid), dim3(NWAVES * 64), kargs, LDS_BYTES, stream);
    if (e != hipSuccess) fprintf(stderr, "kernel_launch: cooperative launch failed: %s (grid %d)\n", hipGetErrorString(e), grid);
#ifdef PROBE_PHASE
    a.ph_lo = PROBE_PHASE; a.ph_hi = PROBE_PHASE + 1; hipLaunchKernelGGL(mk_fwd, dim3(grid), dim3(NWAVES * 64), LDS_BYTES, stream, a);
#endif
#else
    for (int p = 0; p < NPHASE; ++p) { a.ph_lo = p; a.ph_hi = p + 1; hipLaunchKernelGGL(mk_fwd, dim3(grid), dim3(NWAVES * 64), LDS_BYTES, stream, a); }
#endif
}
```
